# Optimizing an MI355X kernel written in HIP

```python
import jax, jax.numpy as jnp
from jax import lax
import numpy as np

D_MODEL = 1024
BATCH = 8
SEQ = 4096
DEPTH = 4

GRID_W = 64
CTX_LEN = 256
N_MIXERS = 2
N_MOD = 6
CHUNK_A = 128
A_WIDTH = D_MODEL
A_GROUPS = 8
A_GROUP_DIM = A_WIDTH // A_GROUPS
RET_HEADS = 4
RET_DK = D_MODEL // RET_HEADS
RET_DV = D_MODEL // RET_HEADS
RET_CHUNK = 128
ROPE_BASE = 10000.0
N_EXPERTS = 16
EC_CAPACITY = 2
EXPERT_FF = D_MODEL
EPS = 1e-6

kernel_name = 'hybrid_gmlp_retention_ec_dit'


def rms_norm(x, g):
    x32 = x.astype(jnp.float32)
    y = x32 * lax.rsqrt(jnp.mean(x32 * x32, axis=-1, keepdims=True) + EPS)
    return (y * g.astype(jnp.float32)).astype(x.dtype)


def layer_norm(x, g, b):
    x32 = x.astype(jnp.float32)
    mu = jnp.mean(x32, axis=-1, keepdims=True)
    var = jnp.mean(jnp.square(x32 - mu), axis=-1, keepdims=True)
    y = (x32 - mu) * lax.rsqrt(var + EPS)
    return (y * g.astype(jnp.float32) + b.astype(jnp.float32)).astype(x.dtype)


def head_norm(o):
    mu = jnp.mean(o, axis=-1, keepdims=True)
    var = jnp.mean(jnp.square(o - mu), axis=-1, keepdims=True)
    return (o - mu) * lax.rsqrt(var + EPS)


def modulate(h, shift, scale):
    return h * (1.0 + scale) + shift


def chunk_gmlp(h, w_in, ln_g, ln_b, w_s, b_s, w_out):
    bsz, n, _ = h.shape
    z = jax.nn.gelu(h @ w_in)
    u, v = jnp.split(z, 2, axis=-1)
    v = layer_norm(v, ln_g, ln_b)
    v = v.reshape(bsz, n // CHUNK_A, CHUNK_A, A_GROUPS, A_GROUP_DIM)
    s = jnp.einsum('gnm,bcmgd->bcngd', w_s, v) + jnp.swapaxes(b_s, 0, 1)[None, None, :, :, None].astype(v.dtype)
    return (u * s.reshape(bsz, n, A_WIDTH)) @ w_out


def split_heads(t, d):
    bsz, n, _ = t.shape
    return t.reshape(bsz, n, RET_HEADS, d).transpose(0, 2, 1, 3)


def axial_rope(t):
    n = t.shape[2]
    rows = n // GRID_W
    pos_r = jnp.repeat(jnp.arange(rows), GRID_W).astype(jnp.float32)
    pos_c = jnp.tile(jnp.arange(GRID_W), rows).astype(jnp.float32)
    n_freq = RET_DK // 4
    inv = jnp.power(ROPE_BASE, -jnp.arange(n_freq, dtype=jnp.float32) / n_freq)
    ang = jnp.concatenate([pos_r[:, None] * inv[None], pos_c[:, None] * inv[None]], axis=-1)
    cos, sin = jnp.cos(ang), jnp.sin(ang)
    t1, t2 = jnp.split(t, 2, axis=-1)
    return jnp.concatenate([t1 * cos - t2 * sin, t1 * sin + t2 * cos], axis=-1)


def decay_tables(log_g, strict):
    idx = jnp.arange(RET_CHUNK, dtype=jnp.float32)
    diff = idx[:, None] - idx[None, :]
    mask = (diff > 0) if strict else (diff >= 0)
    intra = jnp.where(mask, jnp.exp(jnp.where(mask, diff, 0.0)[None] * log_g[:, None, None]), 0.0)
    q_dec = jnp.exp((idx + 1.0)[None] * log_g[:, None])
    k_dec = jnp.exp((RET_CHUNK - 1.0 - idx)[None] * log_g[:, None])
    chunk_dec = jnp.exp(RET_CHUNK * log_g)
    return intra, q_dec, k_dec, chunk_dec


def retention_scan(q, k, v, log_g, s0, strict):
    bsz, h, n, _ = q.shape
    nc = n // RET_CHUNK
    intra, q_dec, k_dec, chunk_dec = decay_tables(log_g, strict)

    def to_chunks(t):
        return jnp.moveaxis(t.reshape(bsz, h, nc, RET_CHUNK, t.shape[-1]), 2, 0)

    def step(s, qkv):
        qc, kc, vc = qkv
        att = jnp.einsum('bhnk,bhmk->bhnm', qc, kc) * intra[None]
        o = jnp.einsum('bhnm,bhmv->bhnv', att, vc) + jnp.einsum('bhnk,bhkv->bhnv', qc * q_dec[None, :, :, None], s)
        s = chunk_dec[None, :, None, None] * s + jnp.einsum('bhmk,bhmv->bhkv', kc * k_dec[None, :, :, None], vc)
        return s, o

    s_fin, o = lax.scan(step, s0, (to_chunks(q), to_chunks(k), to_chunks(v)))
    return jnp.moveaxis(o, 0, 2).reshape(bsz, h, n, -1), s_fin


def retention_final_state(k, v, log_g):
    n = k.shape[2]
    w = jnp.exp((n - 1.0 - jnp.arange(n, dtype=jnp.float32))[None] * log_g[:, None])
    return jnp.einsum('bhnk,hn,bhnv->bhkv', k, w, v)


def retention_merge(o_f, o_b, g_f, g_b, w_out, dtype):
    def heads_out(o):
        bsz, h, n, dv = o.shape
        return head_norm(o).transpose(0, 2, 1, 3).reshape(bsz, n, h * dv)
    y = jax.nn.silu(g_f) * heads_out(o_f) + jax.nn.silu(g_b) * heads_out(o_b)
    return y.astype(dtype) @ w_out


def retention_mixer(h_ctx, h_lat, w_in, decay_f, decay_b, w_out, need_ctx_out):
    qk_w = RET_HEADS * RET_DK
    v_w = RET_HEADS * RET_DV
    k_scale = RET_DK ** -0.5
    lg_f = jax.nn.log_sigmoid(decay_f.astype(jnp.float32))
    lg_b = jax.nn.log_sigmoid(decay_b.astype(jnp.float32))

    def flip(t):
        return t[:, :, ::-1]

    def project(h):
        z = (h @ w_in).astype(jnp.float32)
        q, k, v, g_f, g_b = jnp.split(z, [qk_w, 2 * qk_w, 2 * qk_w + v_w, 2 * qk_w + 2 * v_w], axis=-1)
        return split_heads(q, RET_DK), split_heads(k, RET_DK) * k_scale, split_heads(v, RET_DV), g_f, g_b

    bsz = h_ctx.shape[0]
    if need_ctx_out:
        qc, kc, vc, gfc, gbc = project(h_ctx)
        s0 = jnp.zeros((bsz, RET_HEADS, RET_DK, RET_DV), jnp.float32)
        oc_f, s_f = retention_scan(qc, kc, vc, lg_f, s0, False)
        oc_b, s_b = retention_scan(flip(qc), flip(kc), flip(vc), lg_b, s0, True)
        y_ctx = retention_merge(oc_f, flip(oc_b), gfc, gbc, w_out, h_ctx.dtype)
    else:
        z = (h_ctx @ w_in[:, qk_w:2 * qk_w + v_w]).astype(jnp.float32)
        kc = split_heads(z[..., :qk_w], RET_DK) * k_scale
        vc = split_heads(z[..., qk_w:], RET_DV)
        s_f = retention_final_state(kc, vc, lg_f)
        s_b = retention_final_state(flip(kc), flip(vc), lg_b)
        y_ctx = None

    q, k, v, g_f, g_b = project(h_lat)
    q = axial_rope(q)
    k = axial_rope(k)
    o_f, _ = retention_scan(q, k, v, lg_f, s_f, False)
    o_b, _ = retention_scan(flip(q), flip(k), flip(v), lg_b, s_b, True)
    y_lat = retention_merge(o_f, flip(o_b), g_f, g_b, w_out, h_lat.dtype)
    return y_ctx, y_lat


def expert_choice_ffn(h, w_router, w_gate, w_up, w_down):
    bsz, n, d = h.shape
    cap = EC_CAPACITY * n // N_EXPERTS
    aff = jax.nn.softmax((h @ w_router).astype(jnp.float32), axis=-1)
    gate, idx = lax.top_k(jnp.swapaxes(aff, 1, 2), cap)
    xs = jax.vmap(lambda hb, ib: hb[ib])(h, idx)
    hid = jax.nn.silu(jnp.einsum('becd,edf->becf', xs, w_gate)) * jnp.einsum('becd,edf->becf', xs, w_up)
    ye = jnp.einsum('becf,efd->becd', hid, w_down) * gate[..., None].astype(h.dtype)
    return jax.vmap(lambda yb, ib: jnp.zeros((n, d), yb.dtype).at[ib.reshape(-1)].add(yb.reshape(-1, d)))(ye, idx)


def setup_inputs(seed: int = 0) -> dict:
    key = jax.random.key(seed)
    ks = jax.random.split(key, 24)
    n_a = (DEPTH + 1) // 2
    n_b = DEPTH // 2
    f32 = jnp.float32

    def nrm(k, shape, scale):
        return jax.random.normal(k, shape, f32) * scale

    d = D_MODEL
    decay_base = jnp.log(jnp.power(2.0, 5.0 + jnp.arange(RET_HEADS, dtype=f32)) - 1.0)
    return {
        'x': nrm(ks[0], (BATCH, SEQ, d), 1.0),
        'c': nrm(ks[1], (BATCH, d), 1.0),
        'ctx': nrm(ks[2], (BATCH, CTX_LEN, d), 1.0),
        'c_ctx': nrm(ks[3], (d,), 1.0),
        'ada_w': nrm(ks[4], (DEPTH, d, N_MOD * d), 0.5 * d ** -0.5),
        'ada_b': nrm(ks[5], (DEPTH, N_MOD * d), 0.02),
        'norm_mix_g': 1.0 + nrm(ks[6], (DEPTH, d), 0.02),
        'norm_ffn_g': 1.0 + nrm(ks[7], (DEPTH, d), 0.02),
        'a_w_in': nrm(ks[8], (n_a, d, 2 * A_WIDTH), d ** -0.5),
        'a_ln_g': 1.0 + nrm(ks[9], (n_a, A_WIDTH), 0.02),
        'a_ln_b': nrm(ks[10], (n_a, A_WIDTH), 0.02),
        'a_w_s': nrm(ks[11], (n_a, A_GROUPS, CHUNK_A, CHUNK_A), CHUNK_A ** -0.5),
        'a_b_s': 1.0 + nrm(ks[12], (n_a, A_GROUPS, CHUNK_A), 0.02),
        'a_w_out': nrm(ks[13], (n_a, A_WIDTH, d), A_WIDTH ** -0.5),
        'r_w_in': nrm(ks[14], (n_b, d, 2 * RET_HEADS * RET_DK + 3 * RET_HEADS * RET_DV), d ** -0.5),
        'r_decay_f': decay_base[None] + nrm(ks[15], (n_b, RET_HEADS), 0.1),
        'r_decay_b': decay_base[None] + nrm(ks[16], (n_b, RET_HEADS), 0.1),
        'r_w_out': nrm(ks[17], (n_b, RET_HEADS * RET_DV, d), (RET_HEADS * RET_DV) ** -0.5),
        'moe_w_router': nrm(ks[18], (DEPTH, d, N_EXPERTS), d ** -0.5),
        'moe_w_gate': nrm(ks[19], (DEPTH, N_EXPERTS, d, EXPERT_FF), d ** -0.5),
        'moe_w_up': nrm(ks[20], (DEPTH, N_EXPERTS, d, EXPERT_FF), d ** -0.5),
        'moe_w_down': nrm(ks[21], (DEPTH, N_EXPERTS, EXPERT_FF, d), EXPERT_FF ** -0.5),
        'final_norm_g': 1.0 + nrm(ks[22], (d,), 0.02),
    }


def reference(x, c, ctx, c_ctx, ada_w, ada_b, norm_mix_g, norm_ffn_g, a_w_in, a_ln_g, a_ln_b, a_w_s, a_b_s,
              a_w_out, r_w_in, r_decay_f, r_decay_b, r_w_out, moe_w_router, moe_w_gate, moe_w_up, moe_w_down,
              final_norm_g):
    d = D_MODEL
    for i in range(DEPTH):
        last = i == DEPTH - 1
        kind = i % N_MIXERS
        j = i // N_MIXERS
        mod_lat = jax.nn.silu(c) @ ada_w[i] + ada_b[i]
        sh1, sc1, g1, sh2, sc2, g2 = [m[:, None, :] for m in jnp.split(mod_lat, N_MOD, axis=-1)]
        h_lat = modulate(rms_norm(x, norm_mix_g[i]), sh1, sc1)
        ctx_read = (not last) or kind == 1
        if ctx_read:
            n_mod_ctx = N_MOD if not last else 2
            mod_ctx = jax.nn.silu(c_ctx) @ ada_w[i, :, :n_mod_ctx * d] + ada_b[i, :n_mod_ctx * d]
            parts = jnp.split(mod_ctx, n_mod_ctx)
            h_ctx = modulate(rms_norm(ctx, norm_mix_g[i]), parts[0], parts[1])
        if kind == 0:
            y_lat = chunk_gmlp(h_lat, a_w_in[j], a_ln_g[j], a_ln_b[j], a_w_s[j], a_b_s[j], a_w_out[j])
            y_ctx = None if last else chunk_gmlp(h_ctx, a_w_in[j], a_ln_g[j], a_ln_b[j], a_w_s[j], a_b_s[j], a_w_out[j])
        else:
            y_ctx, y_lat = retention_mixer(h_ctx, h_lat, r_w_in[j], r_decay_f[j], r_decay_b[j], r_w_out[j],
                                           not last)
        x = x + g1 * y_lat
        x = x + g2 * expert_choice_ffn(modulate(rms_norm(x, norm_ffn_g[i]), sh2, sc2),
                                       moe_w_router[i], moe_w_gate[i], moe_w_up[i], moe_w_down[i])
        if not last:
            ctx = ctx + parts[2] * y_ctx
            ctx = ctx + parts[5] * expert_choice_ffn(modulate(rms_norm(ctx, norm_ffn_g[i]), parts[3], parts[4]),
                                                     moe_w_router[i], moe_w_gate[i], moe_w_up[i], moe_w_down[i])
    return rms_norm(x, final_norm_g)
```

```cpp
#include <hip/hip_runtime.h>
#include <cstdio>
#include <cstdint>

#ifndef MK_SINGLE
#define MK_SINGLE 1
#endif

#define LAS __attribute__((address_space(3)))
#define GAS __attribute__((address_space(1)))
typedef unsigned short bf16_t;
typedef short bf16x8 __attribute__((ext_vector_type(8)));
typedef float f32x4 __attribute__((ext_vector_type(4)));
typedef float f32x2 __attribute__((ext_vector_type(2)));
typedef unsigned u32x4 __attribute__((ext_vector_type(4)));
typedef unsigned u32x2 __attribute__((ext_vector_type(2)));

constexpr int D = 1024, NB = 8, SEQ = 4096, CTXL = 256, DEPTH = 4;
constexpr int ROWS_L = NB * SEQ, ROWS_C = NB * CTXL, ROWS = ROWS_L + ROWS_C;
constexpr int NEXP = 16, CAP_L = 512, CAP_C = 32, EROWS = NB * CAP_L + NB * CAP_C;
constexpr int TOK = SEQ + CTXL;
constexpr int NH = 4, DH = 256, SCH = 512, NX = SEQ / SCH;
constexpr float EPS = 1e-6f;
constexpr int NMOD = 6 * D;

constexpr size_t MiB = 1u << 20;
constexpr size_t WS_CTL = 0, CTL_ZERO_BYTES = 1 * MiB;
constexpr size_t WS_MOD = 1 * MiB;
constexpr size_t WS_ROPE = 2 * MiB;
constexpr size_t WS_LOGG = 2 * MiB + 65536;
constexpr size_t WS_XC = 3 * MiB;
constexpr size_t WS_AFF = 11 * MiB;
constexpr size_t WS_SLOT = 14 * MiB;
constexpr size_t WS_IDX = 17 * MiB;
constexpr size_t WS_GATE = 17 * MiB + 512 * 1024;
constexpr size_t WS_WAIN = 18 * MiB;
constexpr size_t WS_WAOUT = 26 * MiB;
constexpr size_t WS_WRIN = 30 * MiB;
constexpr size_t WS_WROUT = 50 * MiB;
constexpr size_t WS_WSB = 54 * MiB;
constexpr size_t WS_WGU = 56 * MiB;
constexpr size_t WS_WD = 120 * MiB;
constexpr size_t WS_HA = 152 * MiB;
constexpr size_t WS_BIG = 220 * MiB;
constexpr size_t SZ_ACT = 68 * MiB;
constexpr size_t WS_Q = WS_BIG, WS_K = WS_Q + SZ_ACT, WS_KFT = WS_K + SZ_ACT, WS_KBT = WS_KFT + SZ_ACT, WS_VT = WS_KBT + SZ_ACT, WS_GF = WS_VT + SZ_ACT, WS_GB = WS_GF + SZ_ACT;
constexpr size_t WS_PF = WS_GB + SZ_ACT;
constexpr size_t WS_PB = WS_PF + 100 * MiB;
constexpr size_t WS_UT = WS_PF;
constexpr size_t WS_ST = WS_PB + 100 * MiB;
constexpr size_t WS_END = WS_ST + 72 * MiB;
constexpr size_t WS_OF = WS_KFT, WS_OB = WS_KBT;
constexpr size_t WS_U = WS_BIG, WS_V = WS_U + SZ_ACT, WS_VT2 = WS_V + SZ_ACT;
constexpr size_t WS_XS = WS_BIG;
constexpr size_t WS_HID = WS_XS + 136 * MiB;
constexpr size_t WS_YE = WS_XS;
constexpr size_t PBLK = 65536;
constexpr size_t P_CTX_OFF = (size_t)32 * NX * 3 * PBLK;

constexpr int CW_BAR = 4096;

constexpr int RING_BYTES = 131072;
constexpr int MISC_OFF = RING_BYTES + 320;
constexpr int LDS_BYTES = 147456;

#define VM_WAIT() asm volatile("s_waitcnt vmcnt(0)" ::: "memory")
#define LDS_WAIT() asm volatile("s_waitcnt lgkmcnt(0)" ::: "memory")
__device__ __forceinline__ unsigned cvt_pk_bf16(float lo, float hi) { unsigned r; asm volatile("v_cvt_pk_bf16_f32 %0, %1, %2" : "=v"(r) : "v"(lo), "v"(hi)); return r; }
__device__ __forceinline__ float bf_lo(unsigned u) { return __builtin_bit_cast(float, u << 16); }
__device__ __forceinline__ float bf_hi(unsigned u) { return __builtin_bit_cast(float, u & 0xffff0000u); }
__device__ __forceinline__ float bf1(bf16_t u) { return __builtin_bit_cast(float, (unsigned)u << 16); }
__device__ __forceinline__ bf16_t f2bf(float f) { return (bf16_t)(cvt_pk_bf16(f, 0.f) & 0xffffu); }
__device__ __forceinline__ float fexp2(float x) { return __builtin_amdgcn_exp2f(x); }
__device__ __forceinline__ float frcp(float x) { return __builtin_amdgcn_rcpf(x); }
__device__ __forceinline__ float sigmoidf_(float x) { return frcp(1.0f + fexp2(-1.4426950408889634f * x)); }
__device__ __forceinline__ float siluf_(float x) { return x * sigmoidf_(x); }
__device__ __forceinline__ float gelu_tanh(float x) { const float y = 1.5957691216057308f * (x + 0.044715f * x * x * x); return x * sigmoidf_(y); }
__device__ __forceinline__ float wave_sum(float v) {
#pragma unroll
    for (int o = 1; o < 64; o <<= 1) v += __shfl_xor(v, o);
    return v;
}

#define XB_TMO      128
#define XB_XCNT(j)  (256  + 64 * (j))
#define XB_XSUB(j)  (1280 + 64 * (j))
#define XB_XGEN(j)  (2304 + 64 * (j))
#define XB_TOP      3328
#define XB_TOPGEN   3392
#define XCD_BAR_WORDS 3456
#define XB_SPIN_CAP (1u << 18)
__device__ __forceinline__ unsigned xb_ld(unsigned* p)              { return __hip_atomic_load(p, __ATOMIC_RELAXED, __HIP_MEMORY_SCOPE_AGENT); }
__device__ __forceinline__ unsigned xb_add(unsigned* p, unsigned v) { return __hip_atomic_fetch_add(p, v, __ATOMIC_RELAXED, __HIP_MEMORY_SCOPE_AGENT); }
__device__ __forceinline__ unsigned xb_xcc_id() { return (unsigned)__builtin_amdgcn_s_getreg((3 << 11) | 20) & 0xFu; }
#define XB_SPIN(cond, bar) do { unsigned _sp = 0; while (cond) { __builtin_amdgcn_s_sleep(1); \
    if ((++_sp & 255u) == 0u) { if (xb_ld(&(bar)[XB_TMO])) break; if (_sp > XB_SPIN_CAP) { atomicAdd(&(bar)[XB_TMO], 1u); break; } } } } while (0)
struct XcdBarrier { unsigned* bar; unsigned x; volatile LAS unsigned* st; };
__device__ __forceinline__ XcdBarrier xcd_barrier_post(unsigned* bar, volatile LAS unsigned* st) {
    XcdBarrier b; b.bar = bar; b.x = xb_xcc_id(); b.st = st;
    if (threadIdx.x == 0) (void)xb_add(&bar[XB_XCNT(b.x)], 1u);
    return b;
}
__device__ __forceinline__ void xcd_barrier_complete(unsigned* bar, unsigned x, unsigned& nloc, unsigned& nx) {
    const unsigned G = gridDim.x * gridDim.y * gridDim.z;
    unsigned sum, cnt, mine, sp = 0u;
    for (;;) {
        sum = 0u; cnt = 0u; mine = 0u;
#pragma unroll
        for (unsigned j = 0; j < 16; ++j) { const unsigned c = xb_ld(&bar[XB_XCNT(j)]); sum += c; cnt += (c > 0u) ? 1u : 0u; mine = (j == x) ? c : mine; }
        if (sum == G) break;
        __builtin_amdgcn_s_sleep(1);
        if ((++sp & 255u) == 0u) { if (xb_ld(&bar[XB_TMO])) break; if (sp > XB_SPIN_CAP) { atomicAdd(&bar[XB_TMO], 1u); break; } }
    }
    nloc = mine > 0u ? mine : 1u; nx = cnt > 0u ? cnt : 1u;
}
__device__ __forceinline__ void xcd_barrier(const XcdBarrier& b) {
    asm volatile("s_waitcnt vmcnt(0)" ::: "memory");
    __syncthreads();
    if (threadIdx.x == 0) {
        unsigned* bar = b.bar;
        __builtin_amdgcn_s_waitcnt(0);
        unsigned nloc = b.st[0], nx = b.st[1];
        if (nloc == 0u) { xcd_barrier_complete(bar, b.x, nloc, nx); b.st[0] = nloc; b.st[1] = nx; }
        const unsigned old = xb_add(&bar[XB_XSUB(b.x)], 1u);
        const unsigned gen = old / nloc;
        if (old + 1u == (gen + 1u) * nloc) {
            __builtin_amdgcn_fence(__ATOMIC_RELEASE, "agent");
            asm volatile("s_waitcnt vmcnt(0)" ::: "memory");
            const unsigned og = xb_add(&bar[XB_TOP], 1u);
            const unsigned tg = og / nx;
            if (og + 1u == (tg + 1u) * nx) xb_add(&bar[XB_TOPGEN], 1u);
            else XB_SPIN(xb_ld(&bar[XB_TOPGEN]) == tg, bar);
            __builtin_amdgcn_fence(__ATOMIC_ACQUIRE, "agent");
            xb_add(&bar[XB_XGEN(b.x)], 1u);
            asm volatile("s_waitcnt vmcnt(0)" ::: "memory");
        } else {
            XB_SPIN(xb_ld(&bar[XB_XGEN(b.x)]) == gen, bar);
            __builtin_amdgcn_fence(__ATOMIC_ACQUIRE, "agent");
            asm volatile("s_waitcnt vmcnt(0)" ::: "memory");
        }
    }
    __syncthreads();
}

struct Params {
    const float *x, *c, *ctx, *c_ctx, *ada_w, *ada_b, *norm_mix_g, *norm_ffn_g, *a_w_in, *a_ln_g, *a_ln_b, *a_w_s, *a_b_s, *a_w_out,
                *r_w_in, *r_decay_f, *r_decay_b, *r_w_out, *moe_w_router, *moe_w_gate, *moe_w_up, *moe_w_down, *final_norm_g;
    float* out;
    unsigned char* ws;
    int ph_lo, ph_hi;
};

typedef const __attribute__((address_space(4))) Params* KParams;
__device__ __forceinline__ void load_params(Params& P, KParams k) {
    P.x = k->x; P.c = k->c; P.ctx = k->ctx; P.c_ctx = k->c_ctx; P.ada_w = k->ada_w; P.ada_b = k->ada_b; P.norm_mix_g = k->norm_mix_g; P.norm_ffn_g = k->norm_ffn_g;
    P.a_w_in = k->a_w_in; P.a_ln_g = k->a_ln_g; P.a_ln_b = k->a_ln_b; P.a_w_s = k->a_w_s; P.a_b_s = k->a_b_s; P.a_w_out = k->a_w_out; P.r_w_in = k->r_w_in;
    P.r_decay_f = k->r_decay_f; P.r_decay_b = k->r_decay_b; P.r_w_out = k->r_w_out; P.moe_w_router = k->moe_w_router; P.moe_w_gate = k->moe_w_gate; P.moe_w_up = k->moe_w_up;
    P.moe_w_down = k->moe_w_down; P.final_norm_g = k->final_norm_g; P.out = k->out; P.ws = k->ws; P.ph_lo = k->ph_lo; P.ph_hi = k->ph_hi;
}

namespace gm {
constexpr int BM = 256, BK = 64, HALF = 128, HTB = HALF * BK * 2, NXCD = 8, WGM = 8;
__device__ __forceinline__ int lds_byte(int r, int c) { const int st = (r >> 4) * 2 + (c >> 5), rr = r & 15, cc = c & 31, ob = rr * 64 + cc * 2; return st * 1024 + (ob ^ (((ob >> 9) & 1) << 5)); }
__device__ __forceinline__ void stage_rc(int b, int& R, int& C) { const int st = b / 1024, sb = b % 1024, swz = sb ^ (((sb >> 9) & 1) << 5); R = (st >> 1) * 16 + swz / 64; C = (st & 1) * 32 + (swz % 64) / 2; }

struct Unit { const char* A0; const char* B0; const char* A1; const char* B1; int nt; int i0, i1, i2, i3; };
typedef f32x4 Acc[2][2][4][2];

__device__ __forceinline__ void tile_order(int L, int nM, int nN, int& pm, int& pn) {
    const int nwg = nM * nN; int wgid = L;
    { const int q = nwg / NXCD, r = nwg % NXCD, xcd = wgid % NXCD, off = wgid / NXCD; wgid = (xcd < r ? xcd * (q + 1) : r * (q + 1) + (xcd - r) * q) + off; }
    const int nig = WGM * nN, gid = wgid / nig, fm = gid * WGM, gsz = (nM - fm) < WGM ? (nM - fm) : WGM;
    pm = fm + ((wgid % nig) % gsz); pn = (wgid % nig) / gsz;
}

template <class Epi, class Sched>
__device__ __forceinline__ void gemm_units(LAS unsigned char* lds, const int tid, const Sched& S, const Epi& E) {
    const int wid = __builtin_amdgcn_readfirstlane(tid >> 6), lane = tid & 63, wr = wid >> 2, wc = wid & 3, fr = lane & 15, fq = lane >> 4;
    unsigned sR[2], sC[2];
#pragma unroll
    for (int i = 0; i < 2; ++i) { int R, C; stage_rc(tid * 16 + i * 8192, R, C); sR[i] = (unsigned)R; sC[i] = (unsigned)C * 2u; }
    const unsigned ldsw = (unsigned)wid * 1024u;
    const int aoff = lds_byte(wr * 64 + fr, fq * 8), boff = lds_byte(wc * 32 + fr, fq * 8);
#define G_SA(b, h) (((b) * 2 + (h)) * HTB)
#define G_SB(b, h) ((4 + (b) * 2 + (h)) * HTB)
#define G_STAGE(bufoff, gbase, ld) do { _Pragma("unroll") for (int _i = 0; _i < 2; ++_i) \
        __builtin_amdgcn_global_load_lds((const unsigned*)((const char*)(gbase) + (sR[_i] * (ld) + sC[_i])), (LAS unsigned*)(lds + (bufoff) + ldsw + _i * 8192), 16, 0, 0); } while (0)
#define G_LDA(dst, b, h) do { _Pragma("unroll") for (int m = 0; m < 4; ++m) _Pragma("unroll") for (int k = 0; k < 2; ++k) dst[m][k] = *(const LAS bf16x8*)(lds + G_SA(b, h) + aoff + m * 2048 + k * 1024); } while (0)
#define G_LDB(dst, b, h) do { _Pragma("unroll") for (int n = 0; n < 2; ++n) _Pragma("unroll") for (int k = 0; k < 2; ++k) dst[n][k] = *(const LAS bf16x8*)(lds + G_SB(b, h) + boff + n * 2048 + k * 1024); } while (0)
#define G_MMA(ai, bj, At, Bt) do { __builtin_amdgcn_s_setprio(1); _Pragma("unroll") for (int m = 0; m < 4; ++m) _Pragma("unroll") for (int n = 0; n < 2; ++n) _Pragma("unroll") for (int k = 0; k < 2; ++k) \
        acc[ai][bj][m][n] = __builtin_amdgcn_mfma_f32_16x16x32_bf16(Bt[n][k], At[m][k], acc[ai][bj][m][n], 0, 0, 0); __builtin_amdgcn_s_setprio(0); } while (0)
#define G_WAIT_V(n) asm volatile("s_waitcnt vmcnt(" #n ")" ::: "memory")
#define G_WAIT_L(n) asm volatile("s_waitcnt lgkmcnt(" #n ")" ::: "memory")
#define G_BAR __builtin_amdgcn_s_barrier()
#define G_SCHED __builtin_amdgcn_sched_barrier(0)
    Unit cur, nxt; int ui = 0;
    if (!S.next(0, cur)) return;
    Acc acc;
#pragma unroll
    for (int a = 0; a < 2; ++a)
#pragma unroll
        for (int b = 0; b < 2; ++b)
#pragma unroll
            for (int m = 0; m < 4; ++m)
#pragma unroll
                for (int n = 0; n < 2; ++n) acc[a][b][m][n] = (f32x4){0.f, 0.f, 0.f, 0.f};
    bf16x8 At[4][2], B0[2][2], B1[2][2];
    {
        const char *a0, *b0; unsigned la, lb; S.tile(cur, 0, a0, b0, la, lb);
        const size_t ha = (size_t)HALF * la, hb = (size_t)HALF * lb;
        G_STAGE(G_SB(0, 0), b0, lb); G_STAGE(G_SA(0, 0), a0, la); G_STAGE(G_SB(0, 1), b0 + hb, lb); G_STAGE(G_SA(0, 1), a0 + ha, la);
        if (wr == 1) G_BAR;
        G_WAIT_V(4); G_BAR;
        G_STAGE(G_SB(1, 0), b0 + 128, lb); G_STAGE(G_SA(1, 0), a0 + 128, la); G_STAGE(G_SB(1, 1), b0 + hb + 128, lb);
        G_WAIT_V(6); G_BAR;
    }
    for (;;) {
        const bool has_next = S.next(ui + 1, nxt);
        const int NT = cur.nt;
#pragma unroll 1
        for (int t = 0; t < NT; t += 2) {
            const bool last = (t == NT - 2);
            const char *a1, *b1_; unsigned la1, lb1; S.tile(cur, t + 1, a1, b1_, la1, lb1);
            const char *a2, *b2; unsigned la2, lb2;
            if (!last) S.tile(cur, t + 2, a2, b2, la2, lb2);
            else if (has_next) S.tile(nxt, 0, a2, b2, la2, lb2);
            else S.tile(cur, 0, a2, b2, la2, lb2);
            const char* a3 = a2 + 128; const char* b3 = b2 + 128;
            const size_t ha1 = (size_t)HALF * la1, ha2 = (size_t)HALF * la2, hb2 = (size_t)HALF * lb2;
            if constexpr (Sched::HOOK) { if (t == S.hook_t) E.hook(acc, cur); }
            G_LDB(B0, 0, 0); G_SCHED; G_LDA(At, 0, 0); G_STAGE(G_SA(1, 1), a1 + ha1, la1);
            G_WAIT_L(8); G_BAR; G_WAIT_L(0); G_MMA(0, 0, At, B0); G_BAR; G_SCHED;
            G_LDB(B1, 0, 1); G_STAGE(G_SB(0, 0), b2, lb2);
            G_BAR; G_WAIT_L(0); G_MMA(0, 1, At, B1); G_BAR;
            G_LDA(At, 0, 1); G_STAGE(G_SA(0, 0), a2, la2);
            G_BAR; G_WAIT_L(0); G_MMA(1, 0, At, B0); G_BAR; G_SCHED;
            G_STAGE(G_SB(0, 1), b2 + hb2, lb2);
            G_WAIT_V(6); G_BAR; G_MMA(1, 1, At, B1); G_BAR;
            G_LDB(B0, 1, 0); G_SCHED; G_LDA(At, 1, 0); G_STAGE(G_SA(0, 1), a2 + ha2, la2);
            G_WAIT_L(8); G_BAR; G_WAIT_L(0); G_MMA(0, 0, At, B0); G_BAR; G_SCHED;
            G_LDB(B1, 1, 1); G_STAGE(G_SB(1, 0), b3, lb2);
            G_BAR; G_WAIT_L(0); G_MMA(0, 1, At, B1); G_BAR;
            G_LDA(At, 1, 1); G_STAGE(G_SA(1, 0), a3, la2);
            G_BAR; G_WAIT_L(0); G_MMA(1, 0, At, B0); G_BAR; G_SCHED;
            G_STAGE(G_SB(1, 1), b3 + hb2, lb2);
            G_WAIT_V(6); G_BAR; G_MMA(1, 1, At, B1); G_BAR;
        }
        E(acc, cur);
        if (!has_next) break;
#pragma unroll
        for (int a = 0; a < 2; ++a)
#pragma unroll
            for (int b = 0; b < 2; ++b)
#pragma unroll
                for (int m = 0; m < 4; ++m)
#pragma unroll
                    for (int n = 0; n < 2; ++n) acc[a][b][m][n] = (f32x4){0.f, 0.f, 0.f, 0.f};
        cur = nxt; ++ui;
    }
    G_WAIT_V(0);
    if (wr == 0) G_BAR;
    G_BAR;
#undef G_SA
#undef G_SB
#undef G_STAGE
#undef G_LDA
#undef G_LDB
#undef G_MMA
#undef G_WAIT_V
#undef G_WAIT_L
#undef G_BAR
#undef G_SCHED
}

struct SchedG {
    static constexpr bool HOOK = false;
    const char* A; const char* Bt; unsigned lda0, ldb0; int nt;
    int nM, nN;
    int nM2, nN2, pm2, pn2;
    int tpg_eff, tpg_full;
    size_t bgs;
    int G, c;
    __device__ __forceinline__ void tile(const Unit& u, int kt, const char*& a, const char*& b, unsigned& lda, unsigned& ldb) const { a = u.A0 + (size_t)kt * 128; b = u.B0 + (size_t)kt * 128; lda = lda0; ldb = ldb0; }
    __device__ __forceinline__ bool next(int i, Unit& u) const {
        int L = i * G + c; const int n1 = nM * nN;
        int pm, pn;
        if (L < n1) tile_order(L, nM, nN, pm, pn);
        else { L -= n1; if (L >= nM2 * nN2) return false; tile_order(L, nM2, nN2, pm, pn); pm += pm2; pn += pn2; }
        const int e = pm / tpg_eff, pg = e * tpg_full + (pm - e * tpg_eff);
        u.A0 = A + (size_t)pg * 256 * lda0; u.B0 = Bt + (size_t)e * bgs + (size_t)pn * 256 * ldb0; u.nt = nt; u.i0 = pg; u.i1 = pn; u.i2 = e; u.i3 = 0; u.A1 = u.A0; u.B1 = u.B0;
        return true;
    }
};
struct SchedState {
    static constexpr bool HOOK = false;
    const char* VT; const char* KFT; const char* KBT; unsigned lda0, ldb0; int G, c;
    __device__ __forceinline__ void tile(const Unit& u, int kt, const char*& a, const char*& b, unsigned& lda, unsigned& ldb) const { a = u.A0 + (size_t)kt * 128; b = u.B0 + (size_t)kt * 128; lda = lda0; ldb = ldb0; }
    __device__ __forceinline__ bool next(int i, Unit& u) const {
        const int L = i * G + c; if (L >= 32 * 9 * 2) return false;
        int bh, X, dir;
        if (L < 32 * 8 * 2) { dir = L & 1; X = (L >> 1) & 7; bh = L >> 4; } else { const int r = L - 512; dir = r & 1; bh = r >> 1; X = 8; }
        const size_t off = ((size_t)bh * 256 * TOK + (size_t)X * SCH) * 2;
        u.A0 = VT + off; u.B0 = (dir ? KBT : KFT) + off; u.nt = (X < 8) ? 8 : 4; u.i0 = (bh * 9 + X) * 2 + dir; u.i1 = u.i2 = u.i3 = 0; u.A1 = u.A0; u.B1 = u.B0;
        return true;
    }
};
struct SchedAtt {
    static constexpr bool HOOK = false;
    const char* Q; const char* K; unsigned lda0, ldb0; int nlat, nctx, G, c;
    __device__ __forceinline__ void tile(const Unit& u, int kt, const char*& a, const char*& b, unsigned& lda, unsigned& ldb) const { a = u.A0 + (size_t)kt * 128; b = u.B0 + (size_t)kt * 128; lda = lda0; ldb = ldb0; }
    __device__ __forceinline__ bool next(int i, Unit& u) const {
        const int L = i * G + c; if (L >= nlat + nctx) return false;
        int bh, X, pm, pn; size_t row0;
        if (L < nlat) { pn = L & 1; pm = (L >> 1) & 1; X = (L >> 2) & 7; bh = L >> 5; row0 = (size_t)(bh >> 2) * SEQ + (size_t)X * SCH; }
        else { bh = L - nlat; X = 8; pm = pn = 0; row0 = (size_t)ROWS_L + (size_t)(bh >> 2) * CTXL; }
        const size_t hoff = (size_t)(bh & 3) * DH * 2;
        u.A0 = Q + (row0 + pm * 256) * 2048 + hoff; u.B0 = K + (row0 + pn * 256) * 2048 + hoff; u.nt = 4; u.i0 = bh; u.i1 = X; u.i2 = pm; u.i3 = pn; u.A1 = u.A0; u.B1 = u.B0;
        return true;
    }
};
struct SchedOut {
    static constexpr bool HOOK = true;
    const char* Q; const char* ST; const char* PF; const char* PB; const char* VT;
    unsigned lda0, ldb0, lda1, ldb1; int hook_t; int nlat, nctx, G, c;
    __device__ __forceinline__ void tile(const Unit& u, int kt, const char*& a, const char*& b, unsigned& lda, unsigned& ldb) const {
        const int s = kt >> 2, r = kt & 3;
        if (s == 0) { a = u.A0 + (size_t)r * 128; b = u.B0 + (size_t)r * 128; lda = lda0; ldb = ldb0; }
        else { a = u.A1 + (size_t)(s - 1) * (PBLK * 2) + (size_t)r * 128; b = u.B1 + (size_t)(s - 1) * 512 + (size_t)r * 128; lda = lda1; ldb = ldb1; }
    }
    __device__ __forceinline__ bool next(int i, Unit& u) const {
        const int L = i * G + c; if (L >= nlat + nctx) return false;
        int bh, X, pm, dir; size_t row0;
        if (L < nlat) { dir = L & 1; pm = (L >> 1) & 1; X = (L >> 2) & 7; bh = L >> 5; row0 = (size_t)(bh >> 2) * SEQ + (size_t)X * SCH; }
        else { const int r = L - nlat; dir = r & 1; bh = r >> 1; X = 8; pm = 0; row0 = (size_t)ROWS_L + (size_t)(bh >> 2) * CTXL; }
        u.A0 = Q + (row0 + pm * 256) * 2048 + (size_t)(bh & 3) * DH * 2;
        u.B0 = ST + (size_t)((bh * 9 + X) * 2 + dir) * PBLK * 2;
        const int nblk = X == 8 ? 1 : (dir ? 2 - pm : pm + 1), kb0 = dir ? pm : 0;
        const size_t pbase = X < 8 ? (size_t)((bh * NX + X) * 3 + pm + kb0) * PBLK : P_CTX_OFF + (size_t)bh * PBLK;
        u.A1 = (dir ? PB : PF) + pbase * 2;
        u.B1 = VT + ((size_t)bh * 256 * TOK + (X < 8 ? (size_t)X * SCH : (size_t)SEQ) + (size_t)kb0 * 256) * 2;
        u.nt = 4 + 4 * nblk; u.i0 = bh; u.i1 = X; u.i2 = pm; u.i3 = dir;
        return true;
    }
};

#define EPI_LANE() int _tz = threadIdx.x; asm volatile("" : "+v"(_tz)); const int wr = _tz >> 8, wc = (_tz >> 6) & 3, fr = _tz & 15, fq = (_tz >> 4) & 3
#define EPI_ROWS(ai, m) (128 * (ai) + 64 * wr + 16 * (m) + fr)
#define EPI_COLS(bj, n) (128 * (bj) + 32 * wc + 16 * (n) + 4 * fq)
__device__ __forceinline__ void st_bf4(bf16_t* p, const f32x4 v) { u32x2 w; w.x = cvt_pk_bf16(v[0], v[1]); w.y = cvt_pk_bf16(v[2], v[3]); *(u32x2*)p = w; }

struct EpiGelu {
    bf16_t* U; bf16_t* V;
    __device__ __forceinline__ void operator()(const Acc& acc, const Unit& u) const { EPI_LANE();
        bf16_t* dst = (u.i1 < 4 ? U : V) + (size_t)u.i0 * 256 * D + (u.i1 & 3) * 256;
#pragma unroll
        for (int ai = 0; ai < 2; ++ai)
#pragma unroll
            for (int m = 0; m < 4; ++m) { bf16_t* rp = dst + (size_t)EPI_ROWS(ai, m) * D;
#pragma unroll
                for (int bj = 0; bj < 2; ++bj)
#pragma unroll
                    for (int n = 0; n < 2; ++n) { const f32x4 a = acc[ai][bj][m][n]; st_bf4(rp + EPI_COLS(bj, n), (f32x4){gelu_tanh(a[0]), gelu_tanh(a[1]), gelu_tanh(a[2]), gelu_tanh(a[3])}); } }
    }
};
struct EpiRes {
    const float* xs_l; const float* xs_c; float* xd_l; float* xd_c; const float* gate;
    __device__ __forceinline__ void operator()(const Acc& acc, const Unit& u) const { EPI_LANE();
        const int pm = u.i0, pn = u.i1; const bool lat = pm < 128;
        const float* src = lat ? xs_l + (size_t)pm * 256 * D : xs_c + (size_t)(pm - 128) * 256 * D;
        float* dst = lat ? xd_l + (size_t)pm * 256 * D : xd_c + (size_t)(pm - 128) * 256 * D;
        const float* gp = gate + (size_t)(lat ? (pm >> 4) : 8) * NMOD + pn * 256;
        f32x4 gv[2][2];
#pragma unroll
        for (int bj = 0; bj < 2; ++bj)
#pragma unroll
            for (int n = 0; n < 2; ++n) gv[bj][n] = *(const f32x4*)(gp + EPI_COLS(bj, n));
#pragma unroll
        for (int ai = 0; ai < 2; ++ai)
#pragma unroll
            for (int m = 0; m < 4; ++m) { const size_t ro = (size_t)EPI_ROWS(ai, m) * D + pn * 256;
#pragma unroll
                for (int bj = 0; bj < 2; ++bj)
#pragma unroll
                    for (int n = 0; n < 2; ++n) { const int co = EPI_COLS(bj, n); const f32x4 xv = *(const f32x4*)(src + ro + co); *(f32x4*)(dst + ro + co) = xv + gv[bj][n] * acc[ai][bj][m][n]; } }
    }
};
struct EpiRetIn {
    bf16_t *Q, *K, *KFT, *KBT, *VT, *GF, *GB; const float* rope; const float* logg;
    __device__ __forceinline__ void operator()(const Acc& acc, const Unit& u) const { EPI_LANE();
        const int pm = u.i0, pn = u.i1, part = pn >> 2, h = pn & 3; const bool lat = pm < 128;
        const int b = lat ? (pm >> 4) : (pm - 128), n0 = lat ? (pm & 15) * 256 : 0;
        const size_t grow0 = (size_t)pm * 256;
        if (part == 0 || part == 1) {
            const float sc = part == 1 ? 0.0625f : 1.0f;
            bf16_t* dst = (part == 0 ? Q : K) + grow0 * D + h * DH;
            const float l2f = logg[h], l2b = logg[4 + h];
            const size_t tbase = ((size_t)(b * NH + h) * DH) * TOK + (lat ? 0 : SEQ);
#pragma unroll
            for (int ai = 0; ai < 2; ++ai)
#pragma unroll
                for (int m = 0; m < 4; ++m) {
                    const int row = EPI_ROWS(ai, m), n = n0 + row;
                    const int nloc = lat ? (n & (SCH - 1)) : n, len = lat ? SCH : CTXL;
                    const float df = fexp2(l2f * (float)(len - 1 - nloc)), db = fexp2(l2b * (float)nloc);
                    const int pos = (wc < 2) ? (n >> 6) : (n & 63);
#pragma unroll
                    for (int nn = 0; nn < 2; ++nn) {
                        const int i0 = 32 * wc + 16 * nn + 4 * fq;
                        f32x4 t1 = acc[ai][0][m][nn] * sc, t2 = acc[ai][1][m][nn] * sc, o1, o2;
                        if (lat) {
#pragma unroll
                            for (int j = 0; j < 4; ++j) { const f32x2 cs = *(const f32x2*)(rope + ((size_t)pos * 64 + ((i0 + j) & 63)) * 2);
                                o1[j] = t1[j] * cs.x - t2[j] * cs.y; o2[j] = t1[j] * cs.y + t2[j] * cs.x; }
                        } else { o1 = t1; o2 = t2; }
                        bf16_t* rp = dst + (size_t)row * D;
                        st_bf4(rp + i0, o1); st_bf4(rp + 128 + i0, o2);
                        if (part == 1) {
                            const size_t tok = (size_t)n;
#pragma unroll
                            for (int j = 0; j < 4; ++j) {
                                KFT[tbase + (size_t)(i0 + j) * TOK + tok] = f2bf(o1[j] * df); KFT[tbase + (size_t)(128 + i0 + j) * TOK + tok] = f2bf(o2[j] * df);
                                KBT[tbase + (size_t)(i0 + j) * TOK + tok] = f2bf(o1[j] * db); KBT[tbase + (size_t)(128 + i0 + j) * TOK + tok] = f2bf(o2[j] * db); }
                        }
                    }
                }
        } else if (part == 2) {
            const size_t tbase = ((size_t)(b * NH + h) * DH) * TOK + (lat ? 0 : SEQ);
#pragma unroll
            for (int ai = 0; ai < 2; ++ai)
#pragma unroll
                for (int m = 0; m < 4; ++m) { const size_t tok = (size_t)(n0 + EPI_ROWS(ai, m));
#pragma unroll
                    for (int bj = 0; bj < 2; ++bj)
#pragma unroll
                        for (int nn = 0; nn < 2; ++nn) { const int c0 = EPI_COLS(bj, nn);
#pragma unroll
                            for (int j = 0; j < 4; ++j) VT[tbase + (size_t)(c0 + j) * TOK + tok] = f2bf(acc[ai][bj][m][nn][j]); } }
        } else {
            bf16_t* dst = (part == 3 ? GF : GB) + grow0 * D + h * DH;
#pragma unroll
            for (int ai = 0; ai < 2; ++ai)
#pragma unroll
                for (int m = 0; m < 4; ++m) { bf16_t* rp = dst + (size_t)EPI_ROWS(ai, m) * D;
#pragma unroll
                    for (int bj = 0; bj < 2; ++bj)
#pragma unroll
                        for (int nn = 0; nn < 2; ++nn) { const f32x4 a = acc[ai][bj][m][nn]; st_bf4(rp + EPI_COLS(bj, nn), (f32x4){siluf_(a[0]), siluf_(a[1]), siluf_(a[2]), siluf_(a[3])}); } }
        }
    }
};
struct EpiF32 {
    float* C;
    __device__ __forceinline__ void operator()(const Acc& acc, const Unit& u) const { EPI_LANE();
        float* dst = C + (size_t)u.i0 * PBLK;
#pragma unroll
        for (int ai = 0; ai < 2; ++ai)
#pragma unroll
            for (int m = 0; m < 4; ++m) { float* rp = dst + (size_t)EPI_ROWS(ai, m) * 256;
#pragma unroll
                for (int bj = 0; bj < 2; ++bj)
#pragma unroll
                    for (int n = 0; n < 2; ++n) *(f32x4*)(rp + EPI_COLS(bj, n)) = acc[ai][bj][m][n]; }
    }
};
struct EpiAtt {
    bf16_t* PF; bf16_t* PB; const float* logg;
    template <int DIR> __device__ __forceinline__ void one(const Acc& acc, bf16_t* dst, const float sg, const bool diag, const int dlt, int wr, int wc, int fr, int fq) const {
        float cf[2][2][4];
#pragma unroll
        for (int bj = 0; bj < 2; ++bj)
#pragma unroll
            for (int n = 0; n < 2; ++n)
#pragma unroll
                for (int j = 0; j < 4; ++j) cf[bj][n][j] = fexp2(-sg * (float)(EPI_COLS(bj, n) + j));
#pragma unroll
        for (int ai = 0; ai < 2; ++ai)
#pragma unroll
            for (int m = 0; m < 4; ++m) { const int row = EPI_ROWS(ai, m); const float rf = fexp2(sg * (float)(row + dlt));
                bf16_t* rp = dst + (size_t)row * 256;
#pragma unroll
                for (int bj = 0; bj < 2; ++bj)
#pragma unroll
                    for (int n = 0; n < 2; ++n) { const int c0 = EPI_COLS(bj, n); f32x4 v;
#pragma unroll
                        for (int j = 0; j < 4; ++j) { float w = acc[ai][bj][m][n][j] * (rf * cf[bj][n][j]);
                            if (diag) { const int sd = DIR ? (c0 + j) - row : row - (c0 + j) + 1; w *= (float)min(max(sd, 0), 1); }
                            v[j] = w; }
                        st_bf4(rp + c0, v); }
                __builtin_amdgcn_sched_barrier(0); }
    }
    __device__ __forceinline__ void operator()(const Acc& acc, const Unit& u) const { EPI_LANE();
        const int bh = u.i0, X = u.i1, pm = u.i2, pn = u.i3, h = bh & 3;
        const size_t base = (X < 8 ? (size_t)((bh * NX + X) * 3) * PBLK : P_CTX_OFF + (size_t)bh * PBLK) + (size_t)(pm + pn) * PBLK;
        const bool diag = pm == pn; const int dlt = (pm - pn) * 256;
        if (pn <= pm) one<0>(acc, PF + base, logg[h], diag, dlt, wr, wc, fr, fq);
        if (pn >= pm) one<1>(acc, PB + base, -logg[4 + h], diag, dlt, wr, wc, fr, fq);
    }
};
struct EpiOut {
    bf16_t* OF; bf16_t* OB; const float* logg;
    __device__ __forceinline__ void hook(Acc& acc, const Unit& u) const { EPI_LANE();
        const int h = u.i0 & 3, pm = u.i2, dir = u.i3; const float l2 = logg[dir * 4 + h];
#pragma unroll
        for (int ai = 0; ai < 2; ++ai)
#pragma unroll
            for (int m = 0; m < 4; ++m) { const int nl = pm * 256 + EPI_ROWS(ai, m); const float d = fexp2(l2 * (float)(dir == 0 ? nl + 1 : SCH - nl));
#pragma unroll
                for (int bj = 0; bj < 2; ++bj)
#pragma unroll
                    for (int n = 0; n < 2; ++n) acc[ai][bj][m][n] *= d; }
    }
    __device__ __forceinline__ void operator()(const Acc& acc, const Unit& u) const { EPI_LANE();
        const int bh = u.i0, X = u.i1, pm = u.i2, dir = u.i3;
        const size_t row0 = (X < 8 ? (size_t)(bh >> 2) * SEQ + (size_t)X * SCH : (size_t)ROWS_L + (size_t)(bh >> 2) * CTXL) + pm * 256;
        bf16_t* dst = (dir ? OB : OF) + row0 * D + (bh & 3) * DH;
#pragma unroll
        for (int ai = 0; ai < 2; ++ai)
#pragma unroll
            for (int m = 0; m < 4; ++m) { bf16_t* rp = dst + (size_t)EPI_ROWS(ai, m) * D;
#pragma unroll
                for (int bj = 0; bj < 2; ++bj)
#pragma unroll
                    for (int n = 0; n < 2; ++n) st_bf4(rp + EPI_COLS(bj, n), acc[ai][bj][m][n]); }
    }
};
struct EpiSwiglu {
    bf16_t* HID;
    __device__ __forceinline__ void operator()(const Acc& acc, const Unit& u) const { EPI_LANE();
        bf16_t* dst = HID + (size_t)u.i0 * 256 * D + u.i1 * 128;
#pragma unroll
        for (int ai = 0; ai < 2; ++ai)
#pragma unroll
            for (int m = 0; m < 4; ++m) { bf16_t* rp = dst + (size_t)EPI_ROWS(ai, m) * D;
#pragma unroll
                for (int n = 0; n < 2; ++n) { const f32x4 g = acc[ai][0][m][n], w = acc[ai][1][m][n];
                    st_bf4(rp + 32 * wc + 16 * n + 4 * fq, (f32x4){siluf_(g[0]) * w[0], siluf_(g[1]) * w[1], siluf_(g[2]) * w[2], siluf_(g[3]) * w[3]}); } }
    }
};
struct EpiDown {
    bf16_t* YE; const float* gate;
    __device__ __forceinline__ void operator()(const Acc& acc, const Unit& u) const { EPI_LANE();
        bf16_t* dst = YE + (size_t)u.i0 * 256 * D + u.i1 * 256; const float* gp = gate + (size_t)u.i0 * 256;
#pragma unroll
        for (int ai = 0; ai < 2; ++ai)
#pragma unroll
            for (int m = 0; m < 4; ++m) { const int row = EPI_ROWS(ai, m); const float gt = gp[row]; bf16_t* rp = dst + (size_t)row * D;
#pragma unroll
                for (int bj = 0; bj < 2; ++bj)
#pragma unroll
                    for (int n = 0; n < 2; ++n) st_bf4(rp + EPI_COLS(bj, n), acc[ai][bj][m][n] * gt); }
    }
};
}

struct Frame {
    LAS unsigned char* lds; int tid, lane, wave, vcu, G, bx;
    unsigned char* ws;
};
__device__ __forceinline__ void frame_init(Frame& F, LAS unsigned char* lds) {
    int tz = threadIdx.x, bz = blockIdx.x, gz = gridDim.x;
    asm volatile("" : "+v"(tz)); asm volatile("" : "+s"(bz)); asm volatile("" : "+s"(gz));
    F.lds = lds; F.tid = tz; F.lane = tz & 63; F.wave = __builtin_amdgcn_readfirstlane(tz >> 6); F.G = gz; F.bx = bz;
    F.vcu = (gz % 8 == 0) ? (bz % 8) * (gz / 8) + bz / 8 : bz; F.ws = nullptr;
}
#define WSP(T, off) ((T*)(F.ws + (off)))

__device__ __forceinline__ void ph_mod(const Frame& F, const Params& p) {
    LAS float* sc = (LAS float*)F.lds;
    LAS float* part = (LAS float*)(F.lds + 36864);
    for (int idx = F.tid; idx < 9 * D; idx += 512) { const int m = idx >> 10, k = idx & 1023; const float v = m < 8 ? p.c[m * D + k] : p.c_ctx[k]; sc[idx] = siluf_(v); }
    __syncthreads();
    float* MOD = WSP(float, WS_MOD);
    for (int t = F.vcu; t < 4 * 48; t += F.G) {
        const int L = t / 48, cb = t % 48;
        float a0[9], a1[9];
#pragma unroll
        for (int m = 0; m < 9; ++m) { a0[m] = 0.f; a1[m] = 0.f; }
        const float* wp = p.ada_w + ((size_t)L * D + F.wave * 128) * NMOD + cb * 128 + F.lane * 2;
        for (int k = 0; k < 128; ++k) {
            const f32x2 w = *(const f32x2*)(wp + (size_t)k * NMOD);
#pragma unroll
            for (int m = 0; m < 9; ++m) { const float s = sc[m * D + F.wave * 128 + k]; a0[m] += s * w.x; a1[m] += s * w.y; }
        }
#pragma unroll
        for (int m = 0; m < 9; ++m) { part[(F.wave * 9 + m) * 128 + F.lane * 2] = a0[m]; part[(F.wave * 9 + m) * 128 + F.lane * 2 + 1] = a1[m]; }
        __syncthreads();
        for (int idx = F.tid; idx < 9 * 128; idx += 512) { const int m = idx >> 7, col = idx & 127; float s = 0.f;
#pragma unroll
            for (int w = 0; w < 8; ++w) s += part[(w * 9 + m) * 128 + col];
            MOD[((size_t)L * 9 + m) * NMOD + cb * 128 + col] = s + p.ada_b[(size_t)L * NMOD + cb * 128 + col]; }
        __syncthreads();
    }
}
__device__ __forceinline__ void ph_tables(const Frame& F, const Params& p) {
    if (F.vcu == F.G - 1) {
        float* rope = WSP(float, WS_ROPE);
        for (int idx = F.tid; idx < 64 * 64; idx += 512) { const int pos = idx >> 6, j = idx & 63;
            const float inv = fexp2(-(float)j * (13.287712379549449f / 64.0f));
            const float ang = (float)pos * inv; float rev = ang * 0.15915494309189535f; rev -= floorf(rev);
            rope[idx * 2] = __builtin_amdgcn_cosf(rev); rope[idx * 2 + 1] = __builtin_amdgcn_sinf(rev); }
        float* logg = WSP(float, WS_LOGG);
        if (F.tid < 16) { const int j = F.tid >> 3, dir = (F.tid >> 2) & 1, h = F.tid & 3; const float x = (dir ? p.r_decay_b : p.r_decay_f)[j * 4 + h];
            logg[F.tid] = -log1pf(expf(-x)) * 1.4426950408889634f; }
    }
}
__device__ __forceinline__ void tr_item(const float* W, int K, int N, bf16_t* WT, int k0, int n0, int out_row0, LAS float* scr, int lane) {
#pragma unroll 8
    for (int i = 0; i < 32; ++i) { const int kk = 2 * i + (lane >> 5); scr[kk * 33 + (lane & 31)] = W[(size_t)(k0 + kk) * N + n0 + (lane & 31)]; }
    LDS_WAIT(); asm volatile("" ::: "memory");
    const int c = lane & 7;
#pragma unroll
    for (int j = 0; j < 4; ++j) { const int n = (lane >> 3) + 8 * j; const LAS float* s = scr + (8 * c) * 33 + n;
        u32x4 o; o.x = cvt_pk_bf16(s[0 * 33], s[1 * 33]); o.y = cvt_pk_bf16(s[2 * 33], s[3 * 33]); o.z = cvt_pk_bf16(s[4 * 33], s[5 * 33]); o.w = cvt_pk_bf16(s[6 * 33], s[7 * 33]);
        *(u32x4*)(WT + (size_t)(out_row0 + n) * K + k0 + 8 * c) = o; }
    LDS_WAIT(); asm volatile("" ::: "memory");
}
__device__ __forceinline__ void ph_wconv_small(const Frame& F, const Params& p) {
    LAS float* scr = (LAS float*)(F.lds + F.wave * 8704);
    const int gw = F.vcu * 8 + F.wave, NGW = F.G * 8;
    constexpr int I_AIN = 16 * 64, I_AOUT = 16 * 32, I_RIN = 16 * 160, I_ROUT = 16 * 32;
    constexpr int NIT = 2 * (I_AIN + I_AOUT + I_RIN + I_ROUT);
    for (int it = gw; it < NIT; it += NGW) {
        int r = it; const int j = r & 1; r >>= 1;
        if (r < I_AIN) { const int nb = r % 64, kb = r / 64; tr_item(p.a_w_in + (size_t)j * D * 2048, D, 2048, WSP(bf16_t, WS_WAIN) + (size_t)j * 2048 * D, kb * 64, nb * 32, nb * 32, scr, F.lane); continue; } r -= I_AIN;
        if (r < I_AOUT) { const int nb = r % 32, kb = r / 32; tr_item(p.a_w_out + (size_t)j * D * D, D, D, WSP(bf16_t, WS_WAOUT) + (size_t)j * D * D, kb * 64, nb * 32, nb * 32, scr, F.lane); continue; } r -= I_AOUT;
        if (r < I_RIN) { const int nb = r % 160, kb = r / 160; tr_item(p.r_w_in + (size_t)j * D * 5120, D, 5120, WSP(bf16_t, WS_WRIN) + (size_t)j * 5120 * D, kb * 64, nb * 32, nb * 32, scr, F.lane); continue; } r -= I_RIN;
        { const int nb = r % 32, kb = r / 32; tr_item(p.r_w_out + (size_t)j * D * D, D, D, WSP(bf16_t, WS_WROUT) + (size_t)j * D * D, kb * 64, nb * 32, nb * 32, scr, F.lane); }
    }
    bf16_t* wsb = WSP(bf16_t, WS_WSB);
    for (int i = (F.vcu * 512 + F.tid) * 4; i < 2 * 8 * 128 * 128; i += F.G * 512 * 4) { const f32x4 v = *(const f32x4*)(p.a_w_s + i); u32x2 w; w.x = cvt_pk_bf16(v[0], v[1]); w.y = cvt_pk_bf16(v[2], v[3]); *(u32x2*)(wsb + i) = w; }
}
__device__ __forceinline__ void ph_wconv_moe(const Frame& F, const Params& p, int L) {
    LAS float* scr = (LAS float*)(F.lds + F.wave * 8704);
    const int gw = F.vcu * 8 + F.wave, NGW = F.G * 8;
    constexpr int IPM = 16 * 32;
    for (int it = gw; it < NEXP * 3 * IPM; it += NGW) {
        const int e = it / (3 * IPM), r = it % (3 * IPM), which = r / IPM, q = r % IPM, nb = q % 32, kb = q / 32, n0 = nb * 32;
        const size_t wo = ((size_t)L * NEXP + e) * D * D;
        if (which < 2) tr_item((which == 0 ? p.moe_w_gate : p.moe_w_up) + wo, D, D, WSP(bf16_t, WS_WGU) + (size_t)e * 2048 * D, kb * 64, n0, (n0 >> 7) * 256 + (n0 & 127) + which * 128, scr, F.lane);
        else tr_item(p.moe_w_down + wo, D, D, WSP(bf16_t, WS_WD) + (size_t)e * D * D, kb * 64, n0, n0, scr, F.lane);
    }
}
__device__ __forceinline__ float* resid_row(const Frame& F, const Params& p, int r) { return r < ROWS_L ? p.out + (size_t)r * D : WSP(float, WS_XC) + (size_t)(r - ROWS_L) * D; }
__device__ __forceinline__ int mod_row(int r) { return r < ROWS_L ? (r >> 12) : 8; }

__device__ __forceinline__ void moe_combine(const Frame& F, int r, int Lp, f32x4 (&v)[4]) {
    const int* slotmap = WSP(int, WS_SLOT); const bf16_t* YE = WSP(bf16_t, WS_YE); const float* MOD = WSP(float, WS_MOD);
    int myslot = -1; if (F.lane < 16) myslot = slotmap[(size_t)r * 16 + F.lane];
    f32x4 s[4];
#pragma unroll
    for (int j = 0; j < 4; ++j) s[j] = (f32x4){0.f, 0.f, 0.f, 0.f};
    for (int e = 0; e < NEXP; ++e) { const int sl = __shfl(myslot, e);
        if (sl >= 0) { const bf16_t* yr = YE + ((size_t)e * EROWS + sl) * D + 4 * F.lane;
#pragma unroll
            for (int j = 0; j < 4; ++j) { const u32x2 w = *(const u32x2*)(yr + 256 * j); s[j] += (f32x4){bf_lo(w.x), bf_hi(w.x), bf_lo(w.y), bf_hi(w.y)}; } } }
    const float* g2 = MOD + ((size_t)Lp * 9 + mod_row(r)) * NMOD + 5 * D + 4 * F.lane;
#pragma unroll
    for (int j = 0; j < 4; ++j) v[j] += *(const f32x4*)(g2 + 256 * j) * s[j];
}
__device__ __forceinline__ void ph_t1(const Frame& F, const Params& p, int L, int nrows) {
    const int gw = F.vcu * 8 + F.wave, NGW = F.G * 8;
    const float* MOD = WSP(float, WS_MOD); bf16_t* HA = WSP(bf16_t, WS_HA);
    for (int r = gw; r < nrows; r += NGW) {
        f32x4 v[4];
        if (L == 0) { const float* xr = (r < ROWS_L ? p.x + (size_t)r * D : p.ctx + (size_t)(r - ROWS_L) * D) + 4 * F.lane;
#pragma unroll
            for (int j = 0; j < 4; ++j) v[j] = *(const f32x4*)(xr + 256 * j); }
        else { float* xr = resid_row(F, p, r) + 4 * F.lane;
#pragma unroll
            for (int j = 0; j < 4; ++j) v[j] = *(const f32x4*)(xr + 256 * j);
            moe_combine(F, r, L - 1, v);
#pragma unroll
            for (int j = 0; j < 4; ++j) *(f32x4*)(xr + 256 * j) = v[j]; }
        float ss = 0.f;
#pragma unroll
        for (int j = 0; j < 4; ++j) ss += (v[j][0] * v[j][0] + v[j][1] * v[j][1]) + (v[j][2] * v[j][2] + v[j][3] * v[j][3]);
        const float rs = 1.0f / sqrtf(wave_sum(ss) * (1.0f / D) + EPS);
        const float* mp = MOD + ((size_t)L * 9 + mod_row(r)) * NMOD + 4 * F.lane; const float* gp = p.norm_mix_g + (size_t)L * D + 4 * F.lane;
        bf16_t* hr = HA + (size_t)r * D + 4 * F.lane;
#pragma unroll
        for (int j = 0; j < 4; ++j) { const f32x4 g = *(const f32x4*)(gp + 256 * j), sh = *(const f32x4*)(mp + 256 * j), sc = *(const f32x4*)(mp + D + 256 * j);
            gm::st_bf4(hr + 256 * j, (v[j] * rs * g) * (sc + 1.0f) + sh); }
    }
}
__device__ __forceinline__ void ph_lnt(const Frame& F, const Params& p, int j, int nchunks) {
    const bf16_t* V = WSP(bf16_t, WS_V); bf16_t* VT2 = WSP(bf16_t, WS_VT2);
    LAS float* stat = (LAS float*)F.lds;
    LAS bf16_t* T = (LAS bf16_t*)(F.lds + 1024);
    const float* lg = p.a_ln_g + (size_t)j * D; const float* lb = p.a_ln_b + (size_t)j * D;
    for (int ch = F.vcu; ch < nchunks; ch += F.G) {
        for (int rr = 0; rr < 16; ++rr) { const int row = F.wave * 16 + rr; const bf16_t* vr = V + ((size_t)ch * 128 + row) * D + F.lane * 16;
            const u32x4 a = *(const u32x4*)vr, b = *(const u32x4*)(vr + 8); float s = 0.f, q = 0.f;
#pragma unroll
            for (int k = 0; k < 4; ++k) { const float x0 = bf_lo(a[k]), x1 = bf_hi(a[k]), y0 = bf_lo(b[k]), y1 = bf_hi(b[k]); s += (x0 + x1) + (y0 + y1); q += (x0 * x0 + x1 * x1) + (y0 * y0 + y1 * y1); }
            s = wave_sum(s); q = wave_sum(q); const float mean = s * (1.0f / D), var = q * (1.0f / D) - mean * mean;
            if (F.lane == 0) { stat[row * 2] = mean; stat[row * 2 + 1] = 1.0f / sqrtf(var + EPS); } }
        __syncthreads();
        for (int cb = 0; cb < 8; ++cb) {
            { const int tok = F.tid >> 2, cs = F.tid & 3; const float mean = stat[tok * 2], rstd = stat[tok * 2 + 1];
              const bf16_t* vr = V + ((size_t)ch * 128 + tok) * D + cb * 128 + cs * 32;
#pragma unroll
              for (int q4 = 0; q4 < 4; ++q4) { const u32x4 a = *(const u32x4*)(vr + q4 * 8);
#pragma unroll
                  for (int k = 0; k < 4; ++k) { const int cl = cs * 32 + q4 * 8 + k * 2, cg = cb * 128 + cl;
                      T[cl * 136 + tok] = f2bf((bf_lo(a[k]) - mean) * rstd * lg[cg] + lb[cg]); T[(cl + 1) * 136 + tok] = f2bf((bf_hi(a[k]) - mean) * rstd * lg[cg + 1] + lb[cg + 1]); } } }
            __syncthreads();
            { const int cl = F.tid >> 2, sg = F.tid & 3; bf16_t* dst = VT2 + ((size_t)ch * D + cb * 128 + cl) * 128 + sg * 32;
#pragma unroll
              for (int q4 = 0; q4 < 4; ++q4) *(u32x4*)(dst + q4 * 8) = *(const LAS u32x4*)(T + cl * 136 + sg * 32 + q4 * 8); }
            __syncthreads();
        }
    }
}
__device__ __forceinline__ void ph_spatial(const Frame& F, const Params& p, int j, int nchunks) {
    const bf16_t* WSB = WSP(bf16_t, WS_WSB) + (size_t)j * 8 * 128 * 128; const bf16_t* VT2 = WSP(bf16_t, WS_VT2); const bf16_t* U = WSP(bf16_t, WS_U); bf16_t* P = WSP(bf16_t, WS_HA);
    LAS bf16_t* As = (LAS bf16_t*)F.lds; LAS bf16_t* Bs = (LAS bf16_t*)(F.lds + 128 * 272);
    const int w4 = F.wave >> 1, w2 = F.wave & 1, fr = F.lane & 15, fq = F.lane >> 4;
    for (int t = F.vcu; t < nchunks * 8; t += F.G) {
        const int ch = t >> 3, g = t & 7;
        { const int row = F.tid >> 2, sg = F.tid & 3; const bf16_t* a = WSB + ((size_t)g * 128 + row) * 128 + sg * 32; const bf16_t* b = VT2 + ((size_t)ch * D + g * 128 + row) * 128 + sg * 32;
#pragma unroll
          for (int q4 = 0; q4 < 4; ++q4) { *(LAS u32x4*)(As + row * 136 + sg * 32 + q4 * 8) = *(const u32x4*)(a + q4 * 8); *(LAS u32x4*)(Bs + row * 136 + sg * 32 + q4 * 8) = *(const u32x4*)(b + q4 * 8); } }
        __syncthreads();
        f32x4 acc[2][4];
#pragma unroll
        for (int mi = 0; mi < 2; ++mi)
#pragma unroll
            for (int ni = 0; ni < 4; ++ni) acc[mi][ni] = (f32x4){0.f, 0.f, 0.f, 0.f};
#pragma unroll
        for (int ks = 0; ks < 4; ++ks) { bf16x8 af[2], bfr[4];
#pragma unroll
            for (int mi = 0; mi < 2; ++mi) af[mi] = *(const LAS bf16x8*)(As + (32 * w4 + 16 * mi + fr) * 136 + ks * 32 + fq * 8);
#pragma unroll
            for (int ni = 0; ni < 4; ++ni) bfr[ni] = *(const LAS bf16x8*)(Bs + (64 * w2 + 16 * ni + fr) * 136 + ks * 32 + fq * 8);
#pragma unroll
            for (int mi = 0; mi < 2; ++mi)
#pragma unroll
                for (int ni = 0; ni < 4; ++ni) acc[mi][ni] = __builtin_amdgcn_mfma_f32_16x16x32_bf16(bfr[ni], af[mi], acc[mi][ni], 0, 0, 0); }
#pragma unroll
        for (int mi = 0; mi < 2; ++mi) { const int n = 32 * w4 + 16 * mi + fr; const float bs = p.a_b_s[((size_t)j * 8 + g) * 128 + n]; const size_t ro = ((size_t)ch * 128 + n) * D + g * 128;
#pragma unroll
            for (int ni = 0; ni < 4; ++ni) { const int d0 = 64 * w2 + 16 * ni + 4 * fq; const u32x2 uu = *(const u32x2*)(U + ro + d0); const f32x4 s = acc[mi][ni] + bs;
                gm::st_bf4(P + ro + d0, (f32x4){bf_lo(uu.x) * s[0], bf_hi(uu.x) * s[1], bf_lo(uu.y) * s[2], bf_hi(uu.y) * s[3]}); } }
        __syncthreads();
    }
}
__device__ __forceinline__ void ph_prefix(const Frame& F, const Params& p, int j) {
    const float* UT = WSP(float, WS_UT); bf16_t* ST = WSP(bf16_t, WS_ST); const float* logg = WSP(float, WS_LOGG) + j * 8;
    const int nq = 32 * 2 * (int)(PBLK / 4);
    for (int q = F.vcu * 512 + F.tid; q < nq; q += F.G * 512) {
        const int e4 = q & (int)(PBLK / 4 - 1), dir = (q >> 14) & 1, bh = q >> 15;
        const float dec = fexp2(logg[dir * 4 + (bh & 3)] * (float)SCH);
        f32x4 S = *(const f32x4*)(UT + (size_t)((bh * 9 + 8) * 2 + dir) * PBLK + e4 * 4);
        gm::st_bf4(ST + (size_t)((bh * 9 + 8) * 2 + dir) * PBLK + e4 * 4, (f32x4){0.f, 0.f, 0.f, 0.f});
        for (int s = 0; s < NX; ++s) { const int X = dir ? (NX - 1 - s) : s; const size_t o = (size_t)((bh * 9 + X) * 2 + dir) * PBLK + e4 * 4;
            gm::st_bf4(ST + o, S); S = S * dec + *(const f32x4*)(UT + o); }
    }
}
__device__ __forceinline__ void ph_headnorm(const Frame& F, int nrows) {
    const int gw = F.vcu * 8 + F.wave, NGW = F.G * 8;
    const bf16_t* OF = WSP(bf16_t, WS_OF); const bf16_t* OB = WSP(bf16_t, WS_OB); const bf16_t* GF = WSP(bf16_t, WS_GF); const bf16_t* GB = WSP(bf16_t, WS_GB); bf16_t* YR = WSP(bf16_t, WS_HA);
    for (int r = gw; r < nrows; r += NGW) { const size_t o = (size_t)r * D + 4 * F.lane;
#pragma unroll
        for (int h = 0; h < 4; ++h) { f32x4 y = (f32x4){0.f, 0.f, 0.f, 0.f};
#pragma unroll
            for (int dir = 0; dir < 2; ++dir) { const u32x2 w = *(const u32x2*)((dir ? OB : OF) + o + 256 * h), gw2 = *(const u32x2*)((dir ? GB : GF) + o + 256 * h);
                const f32x4 v = (f32x4){bf_lo(w.x), bf_hi(w.x), bf_lo(w.y), bf_hi(w.y)}, g = (f32x4){bf_lo(gw2.x), bf_hi(gw2.x), bf_lo(gw2.y), bf_hi(gw2.y)};
                const float mean = wave_sum((v[0] + v[1]) + (v[2] + v[3])) * (1.0f / DH); const f32x4 dlt = v - mean;
                const float var = wave_sum((dlt[0] * dlt[0] + dlt[1] * dlt[1]) + (dlt[2] * dlt[2] + dlt[3] * dlt[3])) * (1.0f / DH);
                y += g * dlt * (1.0f / sqrtf(var + EPS)); }
            gm::st_bf4(YR + o + 256 * h, y); } }
}
__device__ __forceinline__ void ph_router(const Frame& F, const Params& p, int L, int nrows) {
    LAS float* wr = (LAS float*)F.lds;
    for (int i = F.tid * 4; i < D * NEXP; i += 512 * 4) *(LAS f32x4*)(wr + i) = *(const f32x4*)(p.moe_w_router + (size_t)L * D * NEXP + i);
    __syncthreads();
    const int gw = F.vcu * 8 + F.wave, NGW = F.G * 8;
    const float* MOD = WSP(float, WS_MOD); bf16_t* HA = WSP(bf16_t, WS_HA); float* AFF = WSP(float, WS_AFF);
    for (int r = gw; r < nrows; r += NGW) {
        const float* xr = resid_row(F, p, r) + 4 * F.lane; f32x4 v[4]; float ss = 0.f;
#pragma unroll
        for (int j = 0; j < 4; ++j) { v[j] = *(const f32x4*)(xr + 256 * j); ss += (v[j][0] * v[j][0] + v[j][1] * v[j][1]) + (v[j][2] * v[j][2] + v[j][3] * v[j][3]); }
        const float rs = 1.0f / sqrtf(wave_sum(ss) * (1.0f / D) + EPS);
        const float* mp = MOD + ((size_t)L * 9 + mod_row(r)) * NMOD + 3 * D + 4 * F.lane; const float* gp = p.norm_ffn_g + (size_t)L * D + 4 * F.lane;
        bf16_t* hr = HA + (size_t)r * D + 4 * F.lane;
        float lg[16];
#pragma unroll
        for (int e = 0; e < 16; ++e) lg[e] = 0.f;
#pragma unroll
        for (int j = 0; j < 4; ++j) { const f32x4 g = *(const f32x4*)(gp + 256 * j), sh = *(const f32x4*)(mp + 256 * j), sc = *(const f32x4*)(mp + D + 256 * j);
            const f32x4 h2 = (v[j] * rs * g) * (sc + 1.0f) + sh; gm::st_bf4(hr + 256 * j, h2);
#pragma unroll
            for (int q = 0; q < 4; ++q) { const LAS float* wk = wr + (size_t)(4 * F.lane + 256 * j + q) * 16;
#pragma unroll
                for (int e4 = 0; e4 < 4; ++e4) { const f32x4 w = *(const LAS f32x4*)(wk + 4 * e4); lg[4 * e4] += h2[q] * w[0]; lg[4 * e4 + 1] += h2[q] * w[1]; lg[4 * e4 + 2] += h2[q] * w[2]; lg[4 * e4 + 3] += h2[q] * w[3]; } } }
        float mx = -1e30f;
#pragma unroll
        for (int e = 0; e < 16; ++e) { lg[e] = wave_sum(lg[e]); mx = fmaxf(mx, lg[e]); }
        float den = 0.f, mine = 0.f;
#pragma unroll
        for (int e = 0; e < 16; ++e) { lg[e] = __expf(lg[e] - mx); den += lg[e]; }
#pragma unroll
        for (int e = 0; e < 16; ++e) mine = (F.lane == e) ? lg[e] : mine;
        if (F.lane < 16) { const float a = mine / den;
            if (r < ROWS_L) AFF[((size_t)(r >> 12) * 16 + F.lane) * SEQ + (r & (SEQ - 1))] = a;
            else { const int rc = r - ROWS_L; AFF[(size_t)128 * SEQ + ((size_t)(rc >> 8) * 16 + F.lane) * CTXL + (rc & (CTXL - 1))] = a; } }
    }
}
__device__ __forceinline__ void ph_topk(const Frame& F, int ntasks) {
    LAS unsigned* keys = (LAS unsigned*)F.lds;
    LAS unsigned* hist = (LAS unsigned*)(F.lds + 16384);
    LAS unsigned* misc = (LAS unsigned*)(F.lds + 16384 + 1024);
    const float* AFF = WSP(float, WS_AFF); int* IDX = WSP(int, WS_IDX); float* GATE = WSP(float, WS_GATE); int* SLOT = WSP(int, WS_SLOT);
    for (int task = F.vcu; task < ntasks; task += F.G) {
        const bool lat = task < 128; const int be = lat ? task : task - 128, b = be >> 4, e = be & 15;
        const int n = lat ? SEQ : CTXL, cap = lat ? CAP_L : CAP_C;
        const float* src = AFF + (lat ? (size_t)be * SEQ : (size_t)128 * SEQ + (size_t)be * CTXL);
        for (int i = F.tid; i < n; i += 512) keys[i] = __builtin_bit_cast(unsigned, src[i]);
        if (F.tid == 0) { misc[0] = 0u; misc[1] = (unsigned)cap; }
        __syncthreads();
        unsigned mask = 0u;
        for (int pass = 0; pass < 4; ++pass) { const int shift = 24 - 8 * pass;
            if (F.tid < 256) hist[F.tid] = 0u;
            __syncthreads();
            const unsigned prefix = misc[0];
            for (int i = F.tid; i < n; i += 512) { const unsigned k = keys[i]; if ((k & mask) == prefix) __hip_atomic_fetch_add(&hist[(k >> shift) & 255u], 1u, __ATOMIC_RELAXED, __HIP_MEMORY_SCOPE_WORKGROUP); }
            __syncthreads();
            if (F.tid == 0) { unsigned need = misc[1], cum = 0u; int d = 255;
                for (; d > 0; --d) { const unsigned hc = hist[d]; if (cum + hc >= need) break; cum += hc; }
                misc[0] = prefix | ((unsigned)d << shift); misc[1] = need - cum; }
            mask |= 255u << shift;
            __syncthreads();
        }
        const unsigned T = misc[0], need_eq = misc[1];
        const int i0 = F.tid * 8; unsigned cg = 0u, ce = 0u; unsigned kk[8];
#pragma unroll
        for (int q = 0; q < 8; ++q) { const int i = i0 + q; kk[q] = (i < n) ? keys[i] : 0u; cg += (i < n && kk[q] > T) ? 1u : 0u; ce += (i < n && kk[q] == T) ? 1u : 0u; }
        unsigned pk = cg | (ce << 16), incl = pk;
#pragma unroll
        for (int o = 1; o < 64; o <<= 1) { const unsigned t = __shfl_up(incl, o); if (F.lane >= o) incl += t; }
        if (F.lane == 63) misc[8 + F.wave] = incl;
        __syncthreads();
        unsigned wbase = 0u;
#pragma unroll
        for (int w = 0; w < 8; ++w) wbase += (w < F.wave) ? misc[8 + w] : 0u;
        const unsigned excl = wbase + incl - pk; unsigned ng = excl & 0xffffu, ne = excl >> 16;
        const int slotbase = lat ? b * CAP_L : NB * CAP_L + b * CAP_C; const int rowbase = lat ? b * SEQ : ROWS_L + b * CTXL;
#pragma unroll
        for (int q = 0; q < 8; ++q) { const int i = i0 + q; if (i < n) {
                const bool gt = kk[q] > T, eq = kk[q] == T; const bool sel = gt || (eq && ne < need_eq);
                const int slot = slotbase + (int)(ng + (ne < need_eq ? ne : need_eq));
                if (sel) { IDX[e * EROWS + slot] = rowbase + i; GATE[e * EROWS + slot] = __builtin_bit_cast(float, kk[q]); }
                SLOT[(size_t)(rowbase + i) * 16 + e] = sel ? slot : -1;
                ng += gt ? 1u : 0u; ne += eq ? 1u : 0u; } }
        __syncthreads();
    }
}
__device__ __forceinline__ void ph_gather(const Frame& F, int slots_per_expert) {
    const int gw = F.vcu * 8 + F.wave, NGW = F.G * 8;
    const int* IDX = WSP(int, WS_IDX); const bf16_t* HA = WSP(bf16_t, WS_HA); bf16_t* XS = WSP(bf16_t, WS_XS);
    for (int t = gw; t < NEXP * slots_per_expert; t += NGW) { const int e = t / slots_per_expert, s = t % slots_per_expert; const size_t o = (size_t)e * EROWS + s;
        int src = 0; if (F.lane == 0) src = IDX[o]; src = __shfl(src, 0);
        const u32x4* sp = (const u32x4*)(HA + (size_t)src * D) + F.lane; u32x4* dp = (u32x4*)(XS + o * D) + F.lane;
        const u32x4 a = sp[0], b2 = sp[64]; dp[0] = a; dp[64] = b2; }
}
__device__ __forceinline__ void ph_final(const Frame& F, const Params& p) {
    const int gw = F.vcu * 8 + F.wave, NGW = F.G * 8;
    for (int r = gw; r < ROWS_L; r += NGW) { float* xr = p.out + (size_t)r * D + 4 * F.lane; f32x4 v[4];
#pragma unroll
        for (int j = 0; j < 4; ++j) v[j] = *(const f32x4*)(xr + 256 * j);
        moe_combine(F, r, DEPTH - 1, v);
        float ss = 0.f;
#pragma unroll
        for (int j = 0; j < 4; ++j) ss += (v[j][0] * v[j][0] + v[j][1] * v[j][1]) + (v[j][2] * v[j][2] + v[j][3] * v[j][3]);
        const float rs = 1.0f / sqrtf(wave_sum(ss) * (1.0f / D) + EPS);
#pragma unroll
        for (int j = 0; j < 4; ++j) *(f32x4*)(xr + 256 * j) = v[j] * rs * *(const f32x4*)(p.final_norm_g + 4 * F.lane + 256 * j); }
}

constexpr int PH_PER_LAYER = 16, PH_FINAL = 1 + PH_PER_LAYER * DEPTH, PH_TOTAL = PH_FINAL + 1;

template <int ONLY> __global__ void __launch_bounds__(512, 2) mk_fwd(Params p) {
    extern __shared__ __attribute__((aligned(16))) unsigned char lds_raw[];
    Frame F0; frame_init(F0, (LAS unsigned char*)lds_raw);
    volatile LAS unsigned* MISC = (volatile LAS unsigned*)(F0.lds + MISC_OFF);
    if (F0.tid < 32) MISC[F0.tid] = 0u;
    __syncthreads();
#if MK_SINGLE
    XcdBarrier bar = xcd_barrier_post((unsigned*)(p.ws + WS_CTL) + CW_BAR, MISC + 8);
#define SEAM() do { XcdBarrier b_ = bar; asm volatile("" : "+s"(b_.bar)); xcd_barrier(b_); } while (0)
#else
#define SEAM() do {} while (0)
#endif
    const int lo = p.ph_lo, hi = p.ph_hi;
#define IN(k) (lo <= (k) && (k) < hi)
#ifdef ONLY_SITE
#define SITE(s) ((s) == ONLY_SITE && (ONLY < 0 || (s) == ONLY))
#else
#define SITE(s) (ONLY < 0 || (s) == ONLY)
#endif
#define SITE_ENTER() KParams pp_ = (KParams)__builtin_amdgcn_kernarg_segment_ptr(); asm volatile("" : "+s"(pp_)); Params P; load_params(P, pp_); Frame F; frame_init(F, (LAS unsigned char*)lds_raw); F.ws = P.ws; const int c = F.bx; (void)c

    if (SITE(0) && IN(0)) { SITE_ENTER(); ph_mod(F, P); ph_tables(F, P); ph_wconv_small(F, P); SEAM(); }

#pragma unroll 1
    for (int L = 0; L < DEPTH; ++L) {
        const int base = 1 + PH_PER_LAYER * L, j = L >> 1; const bool last = (L == DEPTH - 1), kind1 = (L & 1) != 0;
        if (SITE(1) && IN(base + 0)) { SITE_ENTER(); ph_wconv_moe(F, P, L); ph_t1(F, P, L, ROWS); SEAM(); }
        if (!kind1) {
            if (SITE(2) && IN(base + 1)) {
                SITE_ENTER();
                gm::SchedG S{(const char*)WSP(bf16_t, WS_HA), (const char*)(WSP(bf16_t, WS_WAIN) + (size_t)j * 2048 * D), 2048u, 2048u, 16, ROWS / 256, 8, 0, 0, 0, 0, ROWS / 256, ROWS / 256, 0, F.G, c};
                gm::EpiGelu E{WSP(bf16_t, WS_U), WSP(bf16_t, WS_V)};
                gm::gemm_units(F.lds, F.tid, S, E); SEAM(); }
            if (SITE(3) && IN(base + 2)) { SITE_ENTER(); ph_lnt(F, P, j, ROWS / 128); SEAM(); }
            if (SITE(4) && IN(base + 3)) { SITE_ENTER(); ph_spatial(F, P, j, ROWS / 128); SEAM(); }
            if (SITE(5) && IN(base + 4)) {
                SITE_ENTER();
                gm::SchedG S{(const char*)WSP(bf16_t, WS_HA), (const char*)(WSP(bf16_t, WS_WAOUT) + (size_t)j * D * D), 2048u, 2048u, 16, ROWS / 256, 4, 0, 0, 0, 0, ROWS / 256, ROWS / 256, 0, F.G, c};
                gm::EpiRes E{(L == 0) ? P.x : P.out, (L == 0) ? P.ctx : WSP(float, WS_XC), P.out, WSP(float, WS_XC), WSP(float, WS_MOD) + (size_t)L * 9 * NMOD + 2 * D};
                gm::gemm_units(F.lds, F.tid, S, E); SEAM(); }
        } else {
            if (SITE(6) && IN(base + 1)) {
                SITE_ENTER();
                gm::SchedG S{(const char*)WSP(bf16_t, WS_HA), (const char*)(WSP(bf16_t, WS_WRIN) + (size_t)j * 5120 * D), 2048u, 2048u, 16, last ? 128 : ROWS / 256, 20, last ? 8 : 0, 8, 128, 4, ROWS / 256, ROWS / 256, 0, F.G, c};
                gm::EpiRetIn E{WSP(bf16_t, WS_Q), WSP(bf16_t, WS_K), WSP(bf16_t, WS_KFT), WSP(bf16_t, WS_KBT), WSP(bf16_t, WS_VT), WSP(bf16_t, WS_GF), WSP(bf16_t, WS_GB), WSP(float, WS_ROPE), WSP(float, WS_LOGG) + j * 8};
                gm::gemm_units(F.lds, F.tid, S, E); SEAM(); }
            if (SITE(7) && IN(base + 2)) {
                SITE_ENTER();
                gm::SchedState S{(const char*)WSP(bf16_t, WS_VT), (const char*)WSP(bf16_t, WS_KFT), (const char*)WSP(bf16_t, WS_KBT), (unsigned)TOK * 2u, (unsigned)TOK * 2u, F.G, c};
                gm::EpiF32 E{WSP(float, WS_UT)};
                gm::gemm_units(F.lds, F.tid, S, E); SEAM(); }
            if (SITE(8) && IN(base + 3)) { SITE_ENTER(); ph_prefix(F, P, j); SEAM(); }
            if (SITE(9) && IN(base + 4)) {
                SITE_ENTER();
                gm::SchedAtt S{(const char*)WSP(bf16_t, WS_Q), (const char*)WSP(bf16_t, WS_K), 2048u, 2048u, 32 * NX * 4, last ? 0 : 32, F.G, c};
                gm::EpiAtt E{WSP(bf16_t, WS_PF), WSP(bf16_t, WS_PB), WSP(float, WS_LOGG) + j * 8};
                gm::gemm_units(F.lds, F.tid, S, E); SEAM(); }
            if (SITE(10) && IN(base + 5)) {
                SITE_ENTER();
                gm::SchedOut S{(const char*)WSP(bf16_t, WS_Q), (const char*)WSP(bf16_t, WS_ST), (const char*)WSP(bf16_t, WS_PF), (const char*)WSP(bf16_t, WS_PB), (const char*)WSP(bf16_t, WS_VT),
                               2048u, 512u, 512u, (unsigned)TOK * 2u, 4, 32 * NX * 4, last ? 0 : 64, F.G, c};
                gm::EpiOut E{WSP(bf16_t, WS_OF), WSP(bf16_t, WS_OB), WSP(float, WS_LOGG) + j * 8};
                gm::gemm_units(F.lds, F.tid, S, E); SEAM(); }
            if (SITE(11) && IN(base + 6)) { SITE_ENTER(); ph_headnorm(F, last ? ROWS_L : ROWS); SEAM(); }
            if (SITE(12) && IN(base + 7)) {
                SITE_ENTER();
                const int nM = last ? 128 : ROWS / 256;
                gm::SchedG S{(const char*)WSP(bf16_t, WS_HA), (const char*)(WSP(bf16_t, WS_WROUT) + (size_t)j * D * D), 2048u, 2048u, 16, nM, 4, 0, 0, 0, 0, ROWS / 256, ROWS / 256, 0, F.G, c};
                gm::EpiRes E{P.out, WSP(float, WS_XC), P.out, WSP(float, WS_XC), WSP(float, WS_MOD) + (size_t)L * 9 * NMOD + 2 * D};
                gm::gemm_units(F.lds, F.tid, S, E); SEAM(); }
        }
        if (SITE(13) && IN(base + 8)) { SITE_ENTER(); ph_router(F, P, L, last ? ROWS_L : ROWS); SEAM(); }
        if (SITE(14) && IN(base + 9)) { SITE_ENTER(); ph_topk(F, last ? 128 : 256); SEAM(); }
        if (SITE(15) && IN(base + 10)) { SITE_ENTER(); ph_gather(F, last ? NB * CAP_L : EROWS); SEAM(); }
        {
            const int tpe = last ? 16 : 17;
            if (SITE(16) && IN(base + 11)) {
                SITE_ENTER();
                gm::SchedG S{(const char*)WSP(bf16_t, WS_XS), (const char*)WSP(bf16_t, WS_WGU), 2048u, 2048u, 16, NEXP * tpe, 8, 0, 0, 0, 0, tpe, 17, (size_t)2048 * D * 2, F.G, c};
                gm::EpiSwiglu E{WSP(bf16_t, WS_HID)};
                gm::gemm_units(F.lds, F.tid, S, E); SEAM(); }
            if (SITE(17) && IN(base + 12)) {
                SITE_ENTER();
                gm::SchedG S{(const char*)WSP(bf16_t, WS_HID), (const char*)WSP(bf16_t, WS_WD), 2048u, 2048u, 16, NEXP * tpe, 4, 0, 0, 0, 0, tpe, 17, (size_t)D * D * 2, F.G, c};
                gm::EpiDown E{WSP(bf16_t, WS_YE), WSP(float, WS_GATE)};
                gm::gemm_units(F.lds, F.tid, S, E); SEAM(); }
        }
    }
    if (SITE(18) && IN(PH_FINAL)) { SITE_ENTER(); ph_final(F, P); }
#undef IN
#undef SEAM
#undef SITE
#undef SITE_ENTER
}

#if !MK_SINGLE
typedef void (*KernT)(Params);
template <int S> static KernT kern_of() { return mk_fwd<S>; }
static KernT site_kernel(int site) {
    switch (site) {
        case 0: return kern_of<0>(); case 1: return kern_of<1>(); case 2: return kern_of<2>(); case 3: return kern_of<3>(); case 4: return kern_of<4>();
        case 5: return kern_of<5>(); case 6: return kern_of<6>(); case 7: return kern_of<7>(); case 8: return kern_of<8>(); case 9: return kern_of<9>();
        case 10: return kern_of<10>(); case 11: return kern_of<11>(); case 12: return kern_of<12>(); case 13: return kern_of<13>(); case 14: return kern_of<14>();
        case 15: return kern_of<15>(); case 16: return kern_of<16>(); case 17: return kern_of<17>(); default: return kern_of<18>();
    }
}
static int site_of_phase(int ph) {
    if (ph == 0) return 0;
    if (ph == PH_FINAL) return 18;
    const int L = (ph - 1) / PH_PER_LAYER, q = (ph - 1) % PH_PER_LAYER; const bool kind1 = (L & 1) != 0;
    if (q == 0) return 1;
    if (q >= 8 && q <= 12) return 13 + (q - 8);
    if (q > 12) return -1;
    if (!kind1) return q <= 4 ? 1 + q : -1;
    return 5 + q;
}
#endif
extern "C" void kernel_launch(void* const* d_in, const int* in_sizes, int n_in, void* d_out, int out_size, void* d_ws, size_t ws_size, hipStream_t stream) {
    static int grid = 0;
    if (grid == 0) {
        if (n_in != 23 || ws_size < WS_END) { fprintf(stderr, "kernel_launch: n_in %d ws %zu (need %zu)\n", n_in, ws_size, (size_t)WS_END); grid = -1; return; }
        int dev = 0, cus = 0;
        if (hipGetDevice(&dev) != hipSuccess || hipDeviceGetAttribute(&cus, hipDeviceAttributeMultiprocessorCount, dev) != hipSuccess) { grid = -1; return; }
#if MK_SINGLE
        if (hipFuncSetAttribute((const void*)mk_fwd<-1>, hipFuncAttributeMaxDynamicSharedMemorySize, LDS_BYTES) != hipSuccess) { grid = -1; return; }
#else
        for (int s = 0; s <= 18; ++s) if (hipFuncSetAttribute((const void*)site_kernel(s), hipFuncAttributeMaxDynamicSharedMemorySize, LDS_BYTES) != hipSuccess) { grid = -1; return; }
#endif
        (void)hipGetLastError();
        grid = cus;
    }
    if (grid < 0) return;
    (void)hipMemsetAsync((char*)d_ws + WS_CTL, 0, CTL_ZERO_BYTES, stream);
    Params p{};
    const float** ins = (const float**)&p;
    for (int i = 0; i < 23; ++i) ins[i] = (const float*)d_in[i];
    p.out = (float*)d_out; p.ws = (unsigned char*)d_ws;
#if MK_SINGLE
    p.ph_lo = 0; p.ph_hi = PH_TOTAL;
    hipLaunchKernelGGL(mk_fwd<-1>, dim3(grid), dim3(512), LDS_BYTES, stream, p);
#else
    for (int ph = 0; ph < PH_TOTAL; ++ph) {
        const int site = site_of_phase(ph); if (site < 0) continue;
        p.ph_lo = ph; p.ph_hi = ph + 1;
        hipLaunchKernelGGL(site_kernel(site), dim3(grid), dim3(512), LDS_BYTES, stream, p);
    }
#endif
}
```

```cpp
#include <hip/hip_runtime.h>
#include <cstdio>
#include <cstdint>

#ifndef MK_SINGLE
#define MK_SINGLE 1
#endif

#define LAS __attribute__((address_space(3)))
#define GAS __attribute__((address_space(1)))
typedef unsigned short bf16_t;
typedef short bf16x8 __attribute__((ext_vector_type(8)));
typedef float f32x4 __attribute__((ext_vector_type(4)));
typedef float f32x2 __attribute__((ext_vector_type(2)));
typedef unsigned u32x4 __attribute__((ext_vector_type(4)));
typedef unsigned u32x2 __attribute__((ext_vector_type(2)));

constexpr int D = 1024, NB = 8, SEQ = 4096, CTXL = 256, DEPTH = 4;
constexpr int ROWS_L = NB * SEQ, ROWS_C = NB * CTXL, ROWS = ROWS_L + ROWS_C;
constexpr int NEXP = 16, CAP_L = 512, CAP_C = 32, EROWS = NB * CAP_L + NB * CAP_C;
constexpr int TOK = SEQ + CTXL;
constexpr int NH = 4, DH = 256, SCH = 512, NX = SEQ / SCH;
constexpr float EPS = 1e-6f;
constexpr int NMOD = 6 * D;

constexpr size_t MiB = 1u << 20;
constexpr size_t WS_CTL = 0, CTL_ZERO_BYTES = 65536;
constexpr size_t WS_MOD = 1 * MiB;
constexpr size_t WS_ROPE = 2 * MiB;
constexpr size_t WS_LOGG = 2 * MiB + 65536;
constexpr size_t WS_XC = 3 * MiB;
constexpr size_t WS_AFF = 11 * MiB;
constexpr size_t WS_SLOT = 14 * MiB;
constexpr size_t WS_IDX = 17 * MiB;
constexpr size_t WS_GATE = 17 * MiB + 512 * 1024;
constexpr size_t WS_WAIN = 18 * MiB;
constexpr size_t WS_WAOUT = 26 * MiB;
constexpr size_t WS_WRIN = 30 * MiB;
constexpr size_t WS_WROUT = 50 * MiB;
constexpr size_t WS_WSB = 54 * MiB;
constexpr size_t WS_WGU = 56 * MiB;
constexpr size_t WS_WD = 120 * MiB;
constexpr size_t WS_HA = 152 * MiB;
constexpr size_t WS_BIG = 220 * MiB;
constexpr size_t SZ_ACT = 68 * MiB;
constexpr size_t WS_Q = WS_BIG, WS_K = WS_Q + SZ_ACT, WS_KFT = WS_K + SZ_ACT, WS_KBT = WS_KFT + SZ_ACT, WS_VT = WS_KBT + SZ_ACT, WS_GF = WS_VT + SZ_ACT, WS_GB = WS_GF + SZ_ACT;
constexpr size_t WS_PF = WS_GB + SZ_ACT;
constexpr size_t WS_PB = WS_PF + 100 * MiB;
constexpr size_t WS_UT = WS_PB + 100 * MiB + 72 * MiB;
constexpr size_t WS_ST = WS_PB + 100 * MiB;
constexpr size_t WS_END = WS_UT + 72 * MiB;
constexpr size_t WS_OF = WS_KFT, WS_OB = WS_KBT;
constexpr size_t WS_U = WS_BIG, WS_V = WS_U + SZ_ACT, WS_VT2 = WS_V + SZ_ACT;
constexpr size_t WS_XS = WS_BIG;
constexpr size_t WS_HID = WS_XS + 136 * MiB;
constexpr size_t WS_YE = WS_XS;
constexpr size_t PBLK = 65536;
constexpr size_t P_CTX_OFF = (size_t)32 * NX * 3 * PBLK;

constexpr int CW_BAR = 4096;

constexpr int RING_BYTES = 131072;
constexpr int MISC_OFF = RING_BYTES + 320;
constexpr int TR_OFF = RING_BYTES + 1024;
constexpr int LDS_BYTES = 155648;

#define VM_WAIT() asm volatile("s_waitcnt vmcnt(0)" ::: "memory")
#define LDS_WAIT() asm volatile("s_waitcnt lgkmcnt(0)" ::: "memory")
__device__ __forceinline__ unsigned cvt_pk_bf16(float lo, float hi) { unsigned r; asm volatile("v_cvt_pk_bf16_f32 %0, %1, %2" : "=v"(r) : "v"(lo), "v"(hi)); return r; }
__device__ __forceinline__ float bf_lo(unsigned u) { return __builtin_bit_cast(float, u << 16); }
__device__ __forceinline__ float bf_hi(unsigned u) { return __builtin_bit_cast(float, u & 0xffff0000u); }
__device__ __forceinline__ float bf1(bf16_t u) { return __builtin_bit_cast(float, (unsigned)u << 16); }
__device__ __forceinline__ bf16_t f2bf(float f) { return (bf16_t)(cvt_pk_bf16(f, 0.f) & 0xffffu); }
__device__ __forceinline__ float fexp2(float x) { return __builtin_amdgcn_exp2f(x); }
__device__ __forceinline__ float frcp(float x) { return __builtin_amdgcn_rcpf(x); }
__device__ __forceinline__ float sigmoidf_(float x) { return frcp(1.0f + fexp2(-1.4426950408889634f * x)); }
__device__ __forceinline__ float siluf_(float x) { return x * sigmoidf_(x); }
__device__ __forceinline__ float gelu_tanh(float x) { const float y = 1.5957691216057308f * (x + 0.044715f * x * x * x); return x * sigmoidf_(y); }
__device__ __forceinline__ float wave_sum(float v) {
#pragma unroll
    for (int o = 1; o < 64; o <<= 1) v += __shfl_xor(v, o);
    return v;
}

#define XB_TMO      128
#define XB_XCNT(j)  (256  + 64 * (j))
#define XB_XSUB(j)  (1280 + 64 * (j))
#define XB_XGEN(j)  (2304 + 64 * (j))
#define XB_TOP      3328
#define XB_TOPGEN   3392
#define XCD_BAR_WORDS 3456
#define XB_SPIN_CAP (1u << 18)
__device__ __forceinline__ unsigned xb_ld(unsigned* p)              { return __hip_atomic_load(p, __ATOMIC_RELAXED, __HIP_MEMORY_SCOPE_AGENT); }
__device__ __forceinline__ unsigned xb_add(unsigned* p, unsigned v) { return __hip_atomic_fetch_add(p, v, __ATOMIC_RELAXED, __HIP_MEMORY_SCOPE_AGENT); }
__device__ __forceinline__ unsigned xb_xcc_id() { return (unsigned)__builtin_amdgcn_s_getreg((3 << 11) | 20) & 0xFu; }
#define XB_SPIN(cond, bar) do { unsigned _sp = 0; while (cond) { __builtin_amdgcn_s_sleep(1); \
    if ((++_sp & 255u) == 0u) { if (xb_ld(&(bar)[XB_TMO])) break; if (_sp > XB_SPIN_CAP) { atomicAdd(&(bar)[XB_TMO], 1u); break; } } } } while (0)
struct XcdBarrier { unsigned* bar; unsigned x; volatile LAS unsigned* st; };
__device__ __forceinline__ XcdBarrier xcd_barrier_post(unsigned* bar, volatile LAS unsigned* st) {
    XcdBarrier b; b.bar = bar; b.x = xb_xcc_id(); b.st = st;
    if (threadIdx.x == 0) (void)xb_add(&bar[XB_XCNT(b.x)], 1u);
    return b;
}
__device__ __forceinline__ void xcd_barrier_complete(unsigned* bar, unsigned x, unsigned& nloc, unsigned& nx) {
    const unsigned G = gridDim.x * gridDim.y * gridDim.z;
    unsigned sum, cnt, mine, sp = 0u;
    for (;;) {
        sum = 0u; cnt = 0u; mine = 0u;
#pragma unroll
        for (unsigned j = 0; j < 16; ++j) { const unsigned c = xb_ld(&bar[XB_XCNT(j)]); sum += c; cnt += (c > 0u) ? 1u : 0u; mine = (j == x) ? c : mine; }
        if (sum == G) break;
        __builtin_amdgcn_s_sleep(1);
        if ((++sp & 255u) == 0u) { if (xb_ld(&bar[XB_TMO])) break; if (sp > XB_SPIN_CAP) { atomicAdd(&bar[XB_TMO], 1u); break; } }
    }
    nloc = mine > 0u ? mine : 1u; nx = cnt > 0u ? cnt : 1u;
}
__device__ __forceinline__ void xcd_barrier(const XcdBarrier& b) {
    asm volatile("s_waitcnt vmcnt(0)" ::: "memory");
    __syncthreads();
    if (threadIdx.x == 0) {
        unsigned* bar = b.bar;
        __builtin_amdgcn_s_waitcnt(0);
        unsigned nloc = b.st[0], nx = b.st[1];
        if (nloc == 0u) { xcd_barrier_complete(bar, b.x, nloc, nx); b.st[0] = nloc; b.st[1] = nx; }
        const unsigned old = xb_add(&bar[XB_XSUB(b.x)], 1u);
        const unsigned gen = old / nloc;
        if (old + 1u == (gen + 1u) * nloc) {
            __builtin_amdgcn_fence(__ATOMIC_RELEASE, "agent");
            asm volatile("s_waitcnt vmcnt(0)" ::: "memory");
            const unsigned og = xb_add(&bar[XB_TOP], 1u);
            const unsigned tg = og / nx;
            if (og + 1u == (tg + 1u) * nx) xb_add(&bar[XB_TOPGEN], 1u);
            else XB_SPIN(xb_ld(&bar[XB_TOPGEN]) == tg, bar);
            __builtin_amdgcn_fence(__ATOMIC_ACQUIRE, "agent");
            xb_add(&bar[XB_XGEN(b.x)], 1u);
            asm volatile("s_waitcnt vmcnt(0)" ::: "memory");
        } else {
            XB_SPIN(xb_ld(&bar[XB_XGEN(b.x)]) == gen, bar);
            __builtin_amdgcn_fence(__ATOMIC_ACQUIRE, "agent");
            asm volatile("s_waitcnt vmcnt(0)" ::: "memory");
        }
    }
    __syncthreads();
}

struct Params {
    const float *x, *c, *ctx, *c_ctx, *ada_w, *ada_b, *norm_mix_g, *norm_ffn_g, *a_w_in, *a_ln_g, *a_ln_b, *a_w_s, *a_b_s, *a_w_out,
                *r_w_in, *r_decay_f, *r_decay_b, *r_w_out, *moe_w_router, *moe_w_gate, *moe_w_up, *moe_w_down, *final_norm_g;
    float* out;
    unsigned char* ws;
    int ph_lo, ph_hi;
};

typedef const __attribute__((address_space(4))) Params* KParams;
__device__ __forceinline__ void load_params(Params& P, KParams k) {
    P.x = k->x; P.c = k->c; P.ctx = k->ctx; P.c_ctx = k->c_ctx; P.ada_w = k->ada_w; P.ada_b = k->ada_b; P.norm_mix_g = k->norm_mix_g; P.norm_ffn_g = k->norm_ffn_g;
    P.a_w_in = k->a_w_in; P.a_ln_g = k->a_ln_g; P.a_ln_b = k->a_ln_b; P.a_w_s = k->a_w_s; P.a_b_s = k->a_b_s; P.a_w_out = k->a_w_out; P.r_w_in = k->r_w_in;
    P.r_decay_f = k->r_decay_f; P.r_decay_b = k->r_decay_b; P.r_w_out = k->r_w_out; P.moe_w_router = k->moe_w_router; P.moe_w_gate = k->moe_w_gate; P.moe_w_up = k->moe_w_up;
    P.moe_w_down = k->moe_w_down; P.final_norm_g = k->final_norm_g; P.out = k->out; P.ws = k->ws; P.ph_lo = k->ph_lo; P.ph_hi = k->ph_hi;
}

namespace gm {
constexpr int BM = 256, BK = 64, HALF = 128, HTB = HALF * BK * 2, NXCD = 8, WGM = 4;
__device__ __forceinline__ int lds_byte(int r, int c) { const int st = (r >> 4) * 2 + (c >> 5), rr = r & 15, cc = c & 31, ob = rr * 64 + cc * 2; return st * 1024 + (ob ^ (((ob >> 9) & 1) << 5)); }
__device__ __forceinline__ int perm32(int rho) { const int n = rho >> 4, i = rho & 15; return 8 * (i >> 2) + 4 * n + (i & 3); }
__device__ __forceinline__ void stage_rc(int b, int& R, int& C) { const int st = b / 1024, sb = b % 1024, swz = sb ^ (((sb >> 9) & 1) << 5); R = (st >> 1) * 16 + swz / 64; C = (st & 1) * 32 + (swz % 64) / 2; }

struct Unit { const char* A0; const char* B0; const char* A1; const char* B1; int nt; int i0, i1, i2, i3; };
typedef f32x4 Acc[2][2][4][2];

__device__ __forceinline__ void tile_order(int L, int nM, int nN, int& pm, int& pn) {
    const int nwg = nM * nN; int wgid = L;
    { const int q = nwg / NXCD, r = nwg % NXCD, xcd = wgid % NXCD, off = wgid / NXCD; wgid = (xcd < r ? xcd * (q + 1) : r * (q + 1) + (xcd - r) * q) + off; }
    const int nig = WGM * nN, gid = wgid / nig, fm = gid * WGM, gsz = (nM - fm) < WGM ? (nM - fm) : WGM;
    pm = fm + ((wgid % nig) % gsz); pn = (wgid % nig) / gsz;
}

template <class Epi, class Sched>
__device__ __forceinline__ void gemm_units(LAS unsigned char* lds, const int tid, const Sched& S, const Epi& E) {
    const int wid = __builtin_amdgcn_readfirstlane(tid >> 6), lane = tid & 63, wr = wid >> 2, wc = wid & 3, fr = lane & 15, fq = lane >> 4;
    unsigned sR[2], sRb[2], sC[2];
#pragma unroll
    for (int i = 0; i < 2; ++i) { int R, C; stage_rc(tid * 16 + i * 8192, R, C); sR[i] = (unsigned)R; sC[i] = (unsigned)C * 2u; sRb[i] = Epi::PERM ? (unsigned)((R & ~31) + perm32(R & 31)) : (unsigned)R; }
    const unsigned ldsw = (unsigned)wid * 1024u;
    const int aoff = lds_byte(wr * 64 + fr, fq * 8), boff = lds_byte(wc * 32 + fr, fq * 8);
#define G_SA(b, h) (((b) * 2 + (h)) * HTB)
#define G_SB(b, h) ((4 + (b) * 2 + (h)) * HTB)
#define G_STAGE(bufoff, gbase, ld) do { _Pragma("unroll") for (int _i = 0; _i < 2; ++_i) \
        __builtin_amdgcn_global_load_lds((const unsigned*)((const char*)(gbase) + (sR[_i] * (ld) + sC[_i])), (LAS unsigned*)(lds + (bufoff) + ldsw + _i * 8192), 16, 0, 0); } while (0)
#define G_STAGE_B(bufoff, gbase, ld) do { _Pragma("unroll") for (int _i = 0; _i < 2; ++_i) \
        __builtin_amdgcn_global_load_lds((const unsigned*)((const char*)(gbase) + (sRb[_i] * (ld) + sC[_i])), (LAS unsigned*)(lds + (bufoff) + ldsw + _i * 8192), 16, 0, 0); } while (0)
#define G_STAGE_A(bufoff, abase, ld, h, nx) do { if constexpr (Sched::GATHER) { _Pragma("unroll") for (int _i = 0; _i < 2; ++_i) \
        __builtin_amdgcn_global_load_lds((const unsigned*)((const char*)(abase) + (((nx) ? gn[h][_i] : gc[h][_i]) + sC[_i])), (LAS unsigned*)(lds + (bufoff) + ldsw + _i * 8192), 16, 0, 0); } \
        else { G_STAGE(bufoff, (const char*)(abase) + (size_t)((h) * HALF) * (ld), ld); } } while (0)
#define G_LDA(dst, b, h) do { _Pragma("unroll") for (int m = 0; m < 4; ++m) _Pragma("unroll") for (int k = 0; k < 2; ++k) dst[m][k] = *(const LAS bf16x8*)(lds + G_SA(b, h) + aoff + m * 2048 + k * 1024); } while (0)
#define G_LDB(dst, b, h) do { _Pragma("unroll") for (int n = 0; n < 2; ++n) _Pragma("unroll") for (int k = 0; k < 2; ++k) dst[n][k] = *(const LAS bf16x8*)(lds + G_SB(b, h) + boff + n * 2048 + k * 1024); } while (0)
#define G_MMA(ai, bj, At, Bt) do { __builtin_amdgcn_s_setprio(1); _Pragma("unroll") for (int m = 0; m < 4; ++m) _Pragma("unroll") for (int n = 0; n < 2; ++n) _Pragma("unroll") for (int k = 0; k < 2; ++k) \
        acc[ai][bj][m][n] = __builtin_amdgcn_mfma_f32_16x16x32_bf16(Bt[n][k], At[m][k], acc[ai][bj][m][n], 0, 0, 0); __builtin_amdgcn_s_setprio(0); } while (0)
#define G_WAIT_V(n) asm volatile("s_waitcnt vmcnt(" #n ")" ::: "memory")
#define G_WAIT_L(n) asm volatile("s_waitcnt lgkmcnt(" #n ")" ::: "memory")
#define G_BAR __builtin_amdgcn_s_barrier()
#define G_SCHED __builtin_amdgcn_sched_barrier(0)
    Unit cur, nxt; int ui = 0;
    if (!S.next(0, cur)) return;
    unsigned gc[2][2], gn[2][2];
    if constexpr (Sched::GATHER) {
#pragma unroll
        for (int h = 0; h < 2; ++h)
#pragma unroll
            for (int i = 0; i < 2; ++i) { gc[h][i] = (unsigned)S.gidx[(size_t)cur.i0 * 256 + 128 * h + sR[i]] * S.lda0; gn[h][i] = gc[h][i]; }
    }
    Acc acc;
#pragma unroll
    for (int a = 0; a < 2; ++a)
#pragma unroll
        for (int b = 0; b < 2; ++b)
#pragma unroll
            for (int m = 0; m < 4; ++m)
#pragma unroll
                for (int n = 0; n < 2; ++n) acc[a][b][m][n] = (f32x4){0.f, 0.f, 0.f, 0.f};
    bf16x8 At[4][2], B0[2][2], B1[2][2];
    {
        const char *a0, *b0; unsigned la, lb; S.tile(cur, 0, a0, b0, la, lb);
        const size_t hb = (size_t)HALF * lb;
        G_STAGE_B(G_SB(0, 0), b0, lb); G_STAGE_B(G_SB(0, 1), b0 + hb, lb); G_STAGE_A(G_SA(0, 0), a0, la, 0, false); G_STAGE_A(G_SA(0, 1), a0, la, 1, false);
        if (wr == 1) G_BAR;
        G_WAIT_V(2); G_BAR;
        G_STAGE_B(G_SB(1, 0), b0 + 128, lb); G_STAGE_A(G_SA(1, 0), a0 + 128, la, 0, false); G_STAGE_B(G_SB(1, 1), b0 + hb + 128, lb);
        G_WAIT_V(6); G_BAR;
    }
    for (;;) {
        const bool has_next = S.next(ui + 1, nxt);
        if constexpr (Sched::GATHER) { if (has_next) {
#pragma unroll
            for (int h = 0; h < 2; ++h)
#pragma unroll
                for (int i = 0; i < 2; ++i) gn[h][i] = (unsigned)S.gidx[(size_t)nxt.i0 * 256 + 128 * h + sR[i]] * S.lda0; } }
        const int NT = cur.nt;
#pragma unroll 1
        for (int t = 0; t < NT; t += 2) {
            const bool last = (t == NT - 2);
            const char *a1, *b1_; unsigned la1, lb1; S.tile(cur, t + 1, a1, b1_, la1, lb1);
            const char *a2, *b2; unsigned la2, lb2;
            if (!last) S.tile(cur, t + 2, a2, b2, la2, lb2);
            else if (has_next) S.tile(nxt, 0, a2, b2, la2, lb2);
            else S.tile(cur, 0, a2, b2, la2, lb2);
            const char* a3 = a2 + 128; const char* b3 = b2 + 128;
            const size_t hb2 = (size_t)HALF * lb2;
            if constexpr (Sched::HOOK) { if (t == S.hook_t) E.hook(acc, cur); }
            G_LDB(B0, 0, 0); G_LDB(B1, 0, 1); G_SCHED; G_LDA(At, 0, 0); G_STAGE_A(G_SA(1, 1), a1, la1, 1, false);
            G_WAIT_V(8); G_WAIT_L(0); G_BAR; G_MMA(0, 0, At, B0); G_MMA(0, 1, At, B1); G_BAR; G_SCHED;
            G_LDA(At, 0, 1); G_STAGE_B(G_SB(0, 0), b2, lb2); G_STAGE_B(G_SB(0, 1), b2 + hb2, lb2); G_STAGE_A(G_SA(0, 0), a2, la2, 0, last);
            G_WAIT_V(8); G_WAIT_L(0); G_BAR; G_MMA(1, 0, At, B0); G_MMA(1, 1, At, B1); G_BAR; G_SCHED;
            G_LDB(B0, 1, 0); G_LDB(B1, 1, 1); G_SCHED; G_LDA(At, 1, 0); G_STAGE_A(G_SA(0, 1), a2, la2, 1, last);
            G_WAIT_V(8); G_WAIT_L(0); G_BAR; G_MMA(0, 0, At, B0); G_MMA(0, 1, At, B1); G_BAR; G_SCHED;
            G_LDA(At, 1, 1); G_STAGE_B(G_SB(1, 0), b3, lb2); G_STAGE_B(G_SB(1, 1), b3 + hb2, lb2); G_STAGE_A(G_SA(1, 0), a3, la2, 0, last);
            G_WAIT_V(8); G_WAIT_L(0); G_BAR; G_MMA(1, 0, At, B0); G_MMA(1, 1, At, B1); G_BAR; G_SCHED;
        }
        if (wr == 0) G_BAR;
        E(acc, cur);
        if (!has_next) break;
#pragma unroll
        for (int a = 0; a < 2; ++a)
#pragma unroll
            for (int b = 0; b < 2; ++b)
#pragma unroll
                for (int m = 0; m < 4; ++m)
#pragma unroll
                    for (int n = 0; n < 2; ++n) acc[a][b][m][n] = (f32x4){0.f, 0.f, 0.f, 0.f};
        cur = nxt; ++ui;
        if (wr == 1) G_BAR;
        if constexpr (Sched::GATHER) {
#pragma unroll
            for (int h = 0; h < 2; ++h)
#pragma unroll
                for (int i = 0; i < 2; ++i) gc[h][i] = gn[h][i]; }
    }
    G_WAIT_V(0);
    G_BAR;
#undef G_SA
#undef G_SB
#undef G_STAGE
#undef G_STAGE_A
#undef G_STAGE_B
#undef G_LDA
#undef G_LDB
#undef G_MMA
#undef G_WAIT_V
#undef G_WAIT_L
#undef G_BAR
#undef G_SCHED
}

template <bool GA> struct SchedGT {
    static constexpr bool HOOK = false, GATHER = GA; const int* gidx;
    const char* A; const char* Bt; unsigned lda0, ldb0; int nt;
    int nM, nN;
    int nM2, nN2, pm2, pn2;
    int tpg_eff, tpg_full;
    size_t bgs;
    int G, c;
    __device__ __forceinline__ void tile(const Unit& u, int kt, const char*& a, const char*& b, unsigned& lda, unsigned& ldb) const { a = u.A0 + (size_t)kt * 128; b = u.B0 + (size_t)kt * 128; lda = lda0; ldb = ldb0; }
    __device__ __forceinline__ bool next(int i, Unit& u) const {
        int L = i * G + c; const int n1 = nM * nN;
        int pm, pn;
        if (L < n1) tile_order(L, nM, nN, pm, pn);
        else { L -= n1; if (L >= nM2 * nN2) return false; tile_order(L, nM2, nN2, pm, pn); pm += pm2; pn += pn2; }
        const int e = pm / tpg_eff, pg = e * tpg_full + (pm - e * tpg_eff);
        u.A0 = GA ? A : A + (size_t)pg * 256 * lda0; u.B0 = Bt + (size_t)e * bgs + (size_t)pn * 256 * ldb0; u.nt = nt; u.i0 = pg; u.i1 = pn; u.i2 = e; u.i3 = 0; u.A1 = u.A0; u.B1 = u.B0;
        return true;
    }
};
typedef SchedGT<false> SchedG;
struct SchedState {
    static constexpr bool HOOK = false, GATHER = false;
    const char* VT; const char* KFT; const char* KBT; unsigned lda0, ldb0; int G, c; int u0, nu, coff;
    __device__ __forceinline__ void tile(const Unit& u, int kt, const char*& a, const char*& b, unsigned& lda, unsigned& ldb) const { a = u.A0 + (size_t)kt * 128; b = u.B0 + (size_t)kt * 128; lda = lda0; ldb = ldb0; }
    __device__ __forceinline__ bool next(int i, Unit& u) const {
        const int Lw = i * G + c - coff; if (Lw < 0 || Lw >= nu) return false;
        const int L = u0 + Lw;
        int bh, X, dir;
        { const int xcd = L & 7, jj = L >> 3, q = (jj >> 1) * 8 + xcd; dir = jj & 1;
          if (q < 256) { X = q & 7; bh = q >> 3; } else { X = 8; bh = q - 256; } }
        const size_t off = ((size_t)bh * 256 * TOK + (size_t)X * SCH) * 2;
        u.A0 = VT + off; u.B0 = (dir ? KBT : KFT) + off; u.nt = (X < 8) ? 8 : 4; u.i0 = (bh * 9 + X) * 2 + dir; u.i1 = u.i2 = u.i3 = 0; u.A1 = u.A0; u.B1 = u.B0;
        return true;
    }
};
struct SchedAtt {
    static constexpr bool HOOK = false, GATHER = false;
    const char* Q; const char* K; unsigned lda0, ldb0; int nlat, nctx, G, c;
    __device__ __forceinline__ void tile(const Unit& u, int kt, const char*& a, const char*& b, unsigned& lda, unsigned& ldb) const { a = u.A0 + (size_t)kt * 128; b = u.B0 + (size_t)kt * 128; lda = lda0; ldb = ldb0; }
    __device__ __forceinline__ bool next(int i, Unit& u) const {
        const int L = i * G + c; if (L >= nlat + nctx) return false;
        int bh, X, pm, pn; size_t row0;
        if (L < nlat) { const int xcd = L & 7, jj = L >> 3, q = (jj >> 2) * 8 + xcd; pn = jj & 1; pm = (jj >> 1) & 1; X = q & 7; bh = q >> 3;
            row0 = (size_t)(bh >> 2) * SEQ + (size_t)X * SCH; }
        else { bh = L - nlat; X = 8; pm = pn = 0; row0 = (size_t)ROWS_L + (size_t)(bh >> 2) * CTXL; }
        const size_t hoff = (size_t)(bh & 3) * DH * 2;
        u.A0 = Q + (row0 + pm * 256) * 2048 + hoff; u.B0 = K + (row0 + pn * 256) * 2048 + hoff; u.nt = 4; u.i0 = bh; u.i1 = X; u.i2 = pm; u.i3 = pn; u.A1 = u.A0; u.B1 = u.B0;
        return true;
    }
};
struct SchedOut {
    static constexpr bool HOOK = true, GATHER = false;
    const char* Q; const char* ST; const char* PF; const char* PB; const char* VT;
    unsigned lda0, ldb0, lda1, ldb1; int hook_t; int nlat, nctx, G, c;
    __device__ __forceinline__ void tile(const Unit& u, int kt, const char*& a, const char*& b, unsigned& lda, unsigned& ldb) const {
        const int s = kt >> 2, r = kt & 3;
        if (s == 0) { a = u.A0 + (size_t)r * 128; b = u.B0 + (size_t)r * 128; lda = lda0; ldb = ldb0; }
        else { a = u.A1 + (size_t)(s - 1) * (PBLK * 2) + (size_t)r * 128; b = u.B1 + (size_t)(s - 1) * 512 + (size_t)r * 128; lda = lda1; ldb = ldb1; }
    }
    __device__ __forceinline__ bool next(int i, Unit& u) const {
        const int L = i * G + c; if (L >= nlat + nctx) return false;
        int bh, X, pm, dir; size_t row0;
        if (L < nlat) { const int xcd = L & 7, jj = L >> 3, q = (jj >> 2) * 8 + xcd; dir = jj & 1; pm = (jj >> 1) & 1; X = q & 7; bh = q >> 3;
            row0 = (size_t)(bh >> 2) * SEQ + (size_t)X * SCH; }
        else { const int r = L - nlat, xcd = r & 7, jj = r >> 3; dir = jj & 1; bh = (jj >> 1) * 8 + xcd; X = 8; pm = 0; row0 = (size_t)ROWS_L + (size_t)(bh >> 2) * CTXL; }
        u.A0 = Q + (row0 + pm * 256) * 2048 + (size_t)(bh & 3) * DH * 2;
        u.B0 = ST + (size_t)((bh * 9 + X) * 2 + dir) * PBLK * 2;
        const int nblk = X == 8 ? 1 : (dir ? 2 - pm : pm + 1), kb0 = dir ? pm : 0;
        const size_t pbase = X < 8 ? (size_t)((bh * NX + X) * 3 + pm + kb0) * PBLK : P_CTX_OFF + (size_t)bh * PBLK;
        u.A1 = (dir ? PB : PF) + pbase * 2;
        u.B1 = VT + ((size_t)bh * 256 * TOK + (X < 8 ? (size_t)X * SCH : (size_t)SEQ) + (size_t)kb0 * 256) * 2;
        u.nt = 4 + 4 * nblk; u.i0 = bh; u.i1 = X; u.i2 = pm; u.i3 = dir;
        return true;
    }
};

#define EPI_LANE() int _tz = threadIdx.x; asm volatile("" : "+v"(_tz)); const int wr = _tz >> 8, wc = (_tz >> 6) & 3, fr = _tz & 15, fq = (_tz >> 4) & 3
#define EPI_ROWS(ai, m) (128 * (ai) + 64 * wr + 16 * (m) + fr)
#define EPI_COLS(bj, n) (128 * (bj) + 32 * wc + 16 * (n) + 4 * fq)
#define EPI_COL8(bj) (128 * (bj) + 32 * wc + 8 * fq)
__device__ __forceinline__ void st_bf8(bf16_t* p, const f32x4 a, const f32x4 b) { u32x4 w; w.x = cvt_pk_bf16(a[0], a[1]); w.y = cvt_pk_bf16(a[2], a[3]); w.z = cvt_pk_bf16(b[0], b[1]); w.w = cvt_pk_bf16(b[2], b[3]); *(u32x4*)p = w; }
__device__ __forceinline__ void st_bf4(bf16_t* p, const f32x4 v) { u32x2 w; w.x = cvt_pk_bf16(v[0], v[1]); w.y = cvt_pk_bf16(v[2], v[3]); *(u32x2*)p = w; }

__device__ __forceinline__ float dpp_q1(float v) { return __builtin_bit_cast(float, __builtin_amdgcn_mov_dpp(__builtin_bit_cast(int, v), 0xB1, 0xF, 0xF, true)); }
__device__ __forceinline__ float dpp_q2(float v) { return __builtin_bit_cast(float, __builtin_amdgcn_mov_dpp(__builtin_bit_cast(int, v), 0x4E, 0xF, 0xF, true)); }
__device__ __forceinline__ f32x4 quad_transpose(const f32x4 x, const bool odd, const bool hi) {
    const float s0 = odd ? x[0] : x[1], s1 = odd ? x[2] : x[3]; const float r0 = dpp_q1(s0), r1 = dpp_q1(s1);
    const float a0 = odd ? r0 : x[0], a1 = odd ? x[1] : r0, a2 = odd ? r1 : x[2], a3 = odd ? x[3] : r1;
    const float t0 = hi ? a0 : a2, t1 = hi ? a1 : a3; const float q0 = dpp_q2(t0), q1 = dpp_q2(t1);
    return (f32x4){hi ? q0 : a0, hi ? q1 : a1, hi ? a2 : q0, hi ? a3 : q1};
}
struct EpiGelu {           static constexpr bool PERM = true;
    bf16_t* U; bf16_t* V; float* LNP;
    __device__ __forceinline__ void operator()(const Acc& acc, const Unit& u) const { EPI_LANE();
        const bool isv = u.i1 >= 4;
        bf16_t* dst = (isv ? V : U) + (size_t)u.i0 * 256 * D + (u.i1 & 3) * 256;
#pragma unroll
        for (int ai = 0; ai < 2; ++ai)
#pragma unroll
            for (int m = 0; m < 4; ++m) { const int row = EPI_ROWS(ai, m); bf16_t* rp = dst + (size_t)row * D; float sm = 0.f, sq = 0.f;
#pragma unroll
                for (int bj = 0; bj < 2; ++bj) { f32x4 g[2];
#pragma unroll
                    for (int n = 0; n < 2; ++n) { const f32x4 a = acc[ai][bj][m][n]; g[n] = (f32x4){gelu_tanh(a[0]), gelu_tanh(a[1]), gelu_tanh(a[2]), gelu_tanh(a[3])};
                        sm += (g[n][0] + g[n][1]) + (g[n][2] + g[n][3]); sq += (g[n][0] * g[n][0] + g[n][1] * g[n][1]) + (g[n][2] * g[n][2] + g[n][3] * g[n][3]); }
                    st_bf8(rp + EPI_COL8(bj), g[0], g[1]); }
                if (isv) { sm += __shfl_xor(sm, 16); sq += __shfl_xor(sq, 16); sm += __shfl_xor(sm, 32); sq += __shfl_xor(sq, 32);
                    if (fq == 0) *(f32x2*)(LNP + (((size_t)u.i0 * 256 + row) * 16 + (u.i1 - 4) * 4 + wc) * 2) = (f32x2){sm, sq}; } }
    }
};
struct EpiRes {            static constexpr bool PERM = false;
    const float* xs_l; const float* xs_c; float* xd_l; float* xd_c; const float* gate;
    __device__ __forceinline__ void operator()(const Acc& acc, const Unit& u) const { EPI_LANE();
        const int pm = u.i0, pn = u.i1; const bool lat = pm < 128;
        const float* src = lat ? xs_l + (size_t)pm * 256 * D : xs_c + (size_t)(pm - 128) * 256 * D;
        float* dst = lat ? xd_l + (size_t)pm * 256 * D : xd_c + (size_t)(pm - 128) * 256 * D;
        const float* gp = gate + (size_t)(lat ? (pm >> 4) : 8) * NMOD + pn * 256;
        f32x4 gv[2][2];
#pragma unroll
        for (int bj = 0; bj < 2; ++bj)
#pragma unroll
            for (int n = 0; n < 2; ++n) gv[bj][n] = *(const f32x4*)(gp + EPI_COLS(bj, n));
#pragma unroll
        for (int ai = 0; ai < 2; ++ai)
#pragma unroll
            for (int m = 0; m < 4; ++m) { const size_t ro = (size_t)EPI_ROWS(ai, m) * D + pn * 256;
#pragma unroll
                for (int bj = 0; bj < 2; ++bj)
#pragma unroll
                    for (int n = 0; n < 2; ++n) { const int co = EPI_COLS(bj, n); const f32x4 xv = *(const f32x4*)(src + ro + co); *(f32x4*)(dst + ro + co) = xv + gv[bj][n] * acc[ai][bj][m][n]; } }
    }
};
struct EpiRetIn {          static constexpr bool PERM = true;
    bf16_t *Q, *K, *KFT, *KBT, *VT, *GF, *GB; const float* rope; const float* logg; LAS unsigned char* lds;
    __device__ __forceinline__ void operator()(const Acc& acc, const Unit& u) const { EPI_LANE();
        const int pm = u.i0, pn = u.i1, part = pn >> 2, h = pn & 3; const bool lat = pm < 128;
        const int b = lat ? (pm >> 4) : (pm - 128), n0 = lat ? (pm & 15) * 256 : 0;
        const size_t grow0 = (size_t)pm * 256;
        LAS bf16_t* T = (LAS bf16_t*)(lds + TR_OFF + (_tz >> 6) * 2304);
        const int cr = (_tz >> 2) & 15, tq = _tz & 3;
        const size_t tbase = ((size_t)(b * NH + h) * DH) * TOK + (lat ? 0 : SEQ);
        if (part == 0 || part == 1) {
            const float sc = part == 1 ? 0.0625f : 1.0f;
            bf16_t* dst = (part == 0 ? Q : K) + grow0 * D + h * DH;
            const float l2f = logg[h], l2b = logg[4 + h];
#pragma unroll
            for (int ai = 0; ai < 2; ++ai) {
                const int tr0 = n0 + 128 * ai + 64 * wr + 16 * tq;
                float dfr[16], dbr[16];
                if (part == 1) { const int nl0 = lat ? (tr0 & (SCH - 1)) : tr0, len = lat ? SCH : CTXL;
#pragma unroll
                    for (int i = 0; i < 16; ++i) { dfr[i] = fexp2(l2f * (float)(len - 1 - nl0 - i)); dbr[i] = fexp2(l2b * (float)(nl0 + i)); } }
#pragma unroll
                for (int nn = 0; nn < 2; ++nn) {
                    const int i0 = 32 * wc + 8 * fq + 4 * nn;
                    f32x4 o1[4], o2[4];
#pragma unroll
                    for (int m = 0; m < 4; ++m) {
                        const int row = EPI_ROWS(ai, m), n = n0 + row;
                        const int pos = (wc < 2) ? (n >> 6) : (n & 63);
                        const f32x4 t1 = acc[ai][0][m][nn] * sc, t2 = acc[ai][1][m][nn] * sc;
                        if (lat) {
#pragma unroll
                            for (int j = 0; j < 4; ++j) { const f32x2 cs = *(const f32x2*)(rope + ((size_t)pos * 64 + ((i0 + j) & 63)) * 2);
                                o1[m][j] = t1[j] * cs.x - t2[j] * cs.y; o2[m][j] = t1[j] * cs.y + t2[j] * cs.x; }
                        } else { o1[m] = t1; o2[m] = t2; }
                        bf16_t* rp = dst + (size_t)row * D;
                        st_bf4(rp + i0, o1[m]); st_bf4(rp + 128 + i0, o2[m]);
                    }
                    if (part == 1) {
#pragma unroll
                        for (int half = 0; half < 2; ++half) {
                            asm volatile("" ::: "memory");
#pragma unroll
                            for (int m = 0; m < 4; ++m)
#pragma unroll
                                for (int j = 0; j < 4; ++j) T[(4 * fq + j) * 72 + 16 * m + fr] = f2bf(half ? o2[m][j] : o1[m][j]);
                            asm volatile("" ::: "memory");
                            const u32x4 r0 = *(const LAS u32x4*)(T + cr * 72 + tq * 16), r1 = *(const LAS u32x4*)(T + cr * 72 + tq * 16 + 8);
                            asm volatile("" ::: "memory");
                            const int col = half * 128 + 32 * wc + 8 * (cr >> 2) + 4 * nn + (cr & 3);
                            const size_t to = tbase + (size_t)col * TOK + (size_t)tr0;
                            float vv[16];
#pragma unroll
                            for (int k = 0; k < 4; ++k) { vv[2 * k] = bf_lo(r0[k]); vv[2 * k + 1] = bf_hi(r0[k]); vv[8 + 2 * k] = bf_lo(r1[k]); vv[8 + 2 * k + 1] = bf_hi(r1[k]); }
                            st_bf8(KFT + to, (f32x4){vv[0] * dfr[0], vv[1] * dfr[1], vv[2] * dfr[2], vv[3] * dfr[3]}, (f32x4){vv[4] * dfr[4], vv[5] * dfr[5], vv[6] * dfr[6], vv[7] * dfr[7]});
                            st_bf8(KFT + to + 8, (f32x4){vv[8] * dfr[8], vv[9] * dfr[9], vv[10] * dfr[10], vv[11] * dfr[11]}, (f32x4){vv[12] * dfr[12], vv[13] * dfr[13], vv[14] * dfr[14], vv[15] * dfr[15]});
                            st_bf8(KBT + to, (f32x4){vv[0] * dbr[0], vv[1] * dbr[1], vv[2] * dbr[2], vv[3] * dbr[3]}, (f32x4){vv[4] * dbr[4], vv[5] * dbr[5], vv[6] * dbr[6], vv[7] * dbr[7]});
                            st_bf8(KBT + to + 8, (f32x4){vv[8] * dbr[8], vv[9] * dbr[9], vv[10] * dbr[10], vv[11] * dbr[11]}, (f32x4){vv[12] * dbr[12], vv[13] * dbr[13], vv[14] * dbr[14], vv[15] * dbr[15]});
                        }
                    }
                }
            }
        } else if (part == 2) {
#pragma unroll
            for (int ai = 0; ai < 2; ++ai) { const size_t tr0 = (size_t)(n0 + 128 * ai + 64 * wr + 16 * tq);
#pragma unroll
                for (int bj = 0; bj < 2; ++bj)
#pragma unroll
                    for (int nn = 0; nn < 2; ++nn) {
                        asm volatile("" ::: "memory");
#pragma unroll
                        for (int m = 0; m < 4; ++m)
#pragma unroll
                            for (int j = 0; j < 4; ++j) T[(4 * fq + j) * 72 + 16 * m + fr] = f2bf(acc[ai][bj][m][nn][j]);
                        asm volatile("" ::: "memory");
                        const u32x4 r0 = *(const LAS u32x4*)(T + cr * 72 + tq * 16), r1 = *(const LAS u32x4*)(T + cr * 72 + tq * 16 + 8);
                        asm volatile("" ::: "memory");
                        const int col = 128 * bj + 32 * wc + 8 * (cr >> 2) + 4 * nn + (cr & 3);
                        bf16_t* vp = VT + tbase + (size_t)col * TOK + tr0;
                        *(u32x4*)vp = r0; *(u32x4*)(vp + 8) = r1; } }
        } else {
            bf16_t* dst = (part == 3 ? GF : GB) + grow0 * D + h * DH;
#pragma unroll
            for (int ai = 0; ai < 2; ++ai)
#pragma unroll
                for (int m = 0; m < 4; ++m) { bf16_t* rp = dst + (size_t)EPI_ROWS(ai, m) * D;
#pragma unroll
                    for (int bj = 0; bj < 2; ++bj) { const f32x4 a = acc[ai][bj][m][0], b2 = acc[ai][bj][m][1];
                        st_bf8(rp + EPI_COL8(bj), (f32x4){siluf_(a[0]), siluf_(a[1]), siluf_(a[2]), siluf_(a[3])}, (f32x4){siluf_(b2[0]), siluf_(b2[1]), siluf_(b2[2]), siluf_(b2[3])}); } }
        }
    }
};
struct EpiBlk {            static constexpr bool PERM = true;
    bf16_t* C;
    __device__ __forceinline__ void operator()(const Acc& acc, const Unit& u) const { EPI_LANE();
        bf16_t* dst = C + (size_t)u.i0 * PBLK;
#pragma unroll
        for (int ai = 0; ai < 2; ++ai)
#pragma unroll
            for (int m = 0; m < 4; ++m) { bf16_t* rp = dst + (size_t)EPI_ROWS(ai, m) * 256;
#pragma unroll
                for (int bj = 0; bj < 2; ++bj) st_bf8(rp + EPI_COL8(bj), acc[ai][bj][m][0], acc[ai][bj][m][1]); }
    }
};
struct EpiAtt {            static constexpr bool PERM = true;
    bf16_t* PF; bf16_t* PB; const float* logg;
    template <int DIR> __device__ __forceinline__ void one(const Acc& acc, bf16_t* dst, const float sg, const bool diag, const int dlt, int wr, int wc, int fr, int fq) const {
        float cf[2][2][4];
#pragma unroll
        for (int bj = 0; bj < 2; ++bj)
#pragma unroll
            for (int n = 0; n < 2; ++n)
#pragma unroll
                for (int j = 0; j < 4; ++j) cf[bj][n][j] = fexp2(-sg * (float)(EPI_COL8(bj) + 4 * n + j));
#pragma unroll
        for (int ai = 0; ai < 2; ++ai)
#pragma unroll
            for (int m = 0; m < 4; ++m) { const int row = EPI_ROWS(ai, m); const float rf = fexp2(sg * (float)(row + dlt));
                bf16_t* rp = dst + (size_t)row * 256;
#pragma unroll
                for (int bj = 0; bj < 2; ++bj) { f32x4 v[2];
#pragma unroll
                    for (int n = 0; n < 2; ++n) { const int c0 = EPI_COL8(bj) + 4 * n;
#pragma unroll
                        for (int j = 0; j < 4; ++j) { float w = acc[ai][bj][m][n][j] * (rf * cf[bj][n][j]);
                            if (diag) { const int sd = DIR ? (c0 + j) - row : row - (c0 + j) + 1; w *= (float)min(max(sd, 0), 1); }
                            v[n][j] = w; } }
                    st_bf8(rp + EPI_COL8(bj), v[0], v[1]); }
                __builtin_amdgcn_sched_barrier(0); }
    }
    __device__ __forceinline__ void operator()(const Acc& acc, const Unit& u) const { EPI_LANE();
        const int bh = u.i0, X = u.i1, pm = u.i2, pn = u.i3, h = bh & 3;
        const size_t base = (X < 8 ? (size_t)((bh * NX + X) * 3) * PBLK : P_CTX_OFF + (size_t)bh * PBLK) + (size_t)(pm + pn) * PBLK;
        const bool diag = pm == pn; const int dlt = (pm - pn) * 256;
        if (pn <= pm) one<0>(acc, PF + base, logg[h], diag, dlt, wr, wc, fr, fq);
        if (pn >= pm) one<1>(acc, PB + base, -logg[4 + h], diag, dlt, wr, wc, fr, fq);
    }
};
struct EpiOut {            static constexpr bool PERM = true;
    bf16_t* OF; bf16_t* OB; const float* logg;
    __device__ __forceinline__ void hook(Acc& acc, const Unit& u) const { EPI_LANE();
        const int h = u.i0 & 3, pm = u.i2, dir = u.i3; const float l2 = logg[dir * 4 + h];
#pragma unroll
        for (int ai = 0; ai < 2; ++ai)
#pragma unroll
            for (int m = 0; m < 4; ++m) { const int nl = pm * 256 + EPI_ROWS(ai, m); const float d = fexp2(l2 * (float)(dir == 0 ? nl + 1 : SCH - nl));
#pragma unroll
                for (int bj = 0; bj < 2; ++bj)
#pragma unroll
                    for (int n = 0; n < 2; ++n) acc[ai][bj][m][n] *= d; }
    }
    __device__ __forceinline__ void operator()(const Acc& acc, const Unit& u) const { EPI_LANE();
        const int bh = u.i0, X = u.i1, pm = u.i2, dir = u.i3;
        const size_t row0 = (X < 8 ? (size_t)(bh >> 2) * SEQ + (size_t)X * SCH : (size_t)ROWS_L + (size_t)(bh >> 2) * CTXL) + pm * 256;
        bf16_t* dst = (dir ? OB : OF) + row0 * D + (bh & 3) * DH;
#pragma unroll
        for (int ai = 0; ai < 2; ++ai)
#pragma unroll
            for (int m = 0; m < 4; ++m) { bf16_t* rp = dst + (size_t)EPI_ROWS(ai, m) * D;
#pragma unroll
                for (int bj = 0; bj < 2; ++bj) st_bf8(rp + EPI_COL8(bj), acc[ai][bj][m][0], acc[ai][bj][m][1]); }
    }
};
struct EpiSwiglu {         static constexpr bool PERM = true;
    bf16_t* HID;
    __device__ __forceinline__ void operator()(const Acc& acc, const Unit& u) const { EPI_LANE();
        bf16_t* dst = HID + (size_t)u.i0 * 256 * D + u.i1 * 128;
#pragma unroll
        for (int ai = 0; ai < 2; ++ai)
#pragma unroll
            for (int m = 0; m < 4; ++m) { bf16_t* rp = dst + (size_t)EPI_ROWS(ai, m) * D;
                { f32x4 hv[2];
#pragma unroll
                  for (int n = 0; n < 2; ++n) { const f32x4 g = acc[ai][0][m][n], w = acc[ai][1][m][n]; hv[n] = (f32x4){siluf_(g[0]) * w[0], siluf_(g[1]) * w[1], siluf_(g[2]) * w[2], siluf_(g[3]) * w[3]}; }
                  st_bf8(rp + 32 * wc + 8 * fq, hv[0], hv[1]); } }
    }
};
struct EpiDown {           static constexpr bool PERM = true;
    bf16_t* YE; const float* gate;
    __device__ __forceinline__ void operator()(const Acc& acc, const Unit& u) const { EPI_LANE();
        bf16_t* dst = YE + (size_t)u.i0 * 256 * D + u.i1 * 256;
#pragma unroll
        for (int ai = 0; ai < 2; ++ai)
#pragma unroll
            for (int m = 0; m < 4; ++m) { const int row = EPI_ROWS(ai, m); bf16_t* rp = dst + (size_t)row * D;
#pragma unroll
                for (int bj = 0; bj < 2; ++bj) st_bf8(rp + EPI_COL8(bj), acc[ai][bj][m][0], acc[ai][bj][m][1]); }
    }
};
}

struct Frame {
    LAS unsigned char* lds; int tid, lane, wave, vcu, G, bx;
    unsigned char* ws;
};
__device__ __forceinline__ void frame_init(Frame& F, LAS unsigned char* lds) {
    int tz = threadIdx.x, bz = blockIdx.x, gz = gridDim.x;
    asm volatile("" : "+v"(tz)); asm volatile("" : "+s"(bz)); asm volatile("" : "+s"(gz));
    F.lds = lds; F.tid = tz; F.lane = tz & 63; F.wave = __builtin_amdgcn_readfirstlane(tz >> 6); F.G = gz; F.bx = bz;
    F.vcu = (gz % 8 == 0) ? (bz % 8) * (gz / 8) + bz / 8 : bz; F.ws = nullptr;
}
#define WSP(T, off) ((T*)(F.ws + (off)))

__device__ __forceinline__ void ph_mod(const Frame& F, const Params& p) {
    LAS float* sc = (LAS float*)F.lds;
    LAS float* part = (LAS float*)(F.lds + 36864);
    for (int idx = F.tid; idx < 9 * D; idx += 512) { const int m = idx >> 10, k = idx & 1023; const float v = m < 8 ? p.c[m * D + k] : p.c_ctx[k]; sc[idx] = siluf_(v); }
    __syncthreads();
    float* MOD = WSP(float, WS_MOD);
    for (int t = F.vcu; t < 4 * 48; t += F.G) {
        const int L = t / 48, cb = t % 48;
        float a0[9], a1[9];
#pragma unroll
        for (int m = 0; m < 9; ++m) { a0[m] = 0.f; a1[m] = 0.f; }
        const float* wp = p.ada_w + ((size_t)L * D + F.wave * 128) * NMOD + cb * 128 + F.lane * 2;
        for (int k = 0; k < 128; ++k) {
            const f32x2 w = *(const f32x2*)(wp + (size_t)k * NMOD);
#pragma unroll
            for (int m = 0; m < 9; ++m) { const float s = sc[m * D + F.wave * 128 + k]; a0[m] += s * w.x; a1[m] += s * w.y; }
        }
#pragma unroll
        for (int m = 0; m < 9; ++m) { part[(F.wave * 9 + m) * 128 + F.lane * 2] = a0[m]; part[(F.wave * 9 + m) * 128 + F.lane * 2 + 1] = a1[m]; }
        __syncthreads();
        for (int idx = F.tid; idx < 9 * 128; idx += 512) { const int m = idx >> 7, col = idx & 127; float s = 0.f;
#pragma unroll
            for (int w = 0; w < 8; ++w) s += part[(w * 9 + m) * 128 + col];
            MOD[((size_t)L * 9 + m) * NMOD + cb * 128 + col] = s + p.ada_b[(size_t)L * NMOD + cb * 128 + col]; }
        __syncthreads();
    }
}
__device__ __forceinline__ void ph_tables(const Frame& F, const Params& p) {
    if (F.vcu == F.G - 1) {
        float* rope = WSP(float, WS_ROPE);
        for (int idx = F.tid; idx < 64 * 64; idx += 512) { const int pos = idx >> 6, j = idx & 63;
            const float inv = fexp2(-(float)j * (13.287712379549449f / 64.0f));
            const float ang = (float)pos * inv; float rev = ang * 0.15915494309189535f; rev -= floorf(rev);
            rope[idx * 2] = __builtin_amdgcn_cosf(rev); rope[idx * 2 + 1] = __builtin_amdgcn_sinf(rev); }
        float* logg = WSP(float, WS_LOGG);
        if (F.tid < 16) { const int j = F.tid >> 3, dir = (F.tid >> 2) & 1, h = F.tid & 3; const float x = (dir ? p.r_decay_b : p.r_decay_f)[j * 4 + h];
            logg[F.tid] = -log1pf(expf(-x)) * 1.4426950408889634f; }
    }
}
__device__ __forceinline__ void tr_item(const float* W, int K, int N, bf16_t* WT, int k0, int n0, int out_row0, LAS float* scr, int lane) {
#pragma unroll 8
    for (int i = 0; i < 32; ++i) { const int kk = 2 * i + (lane >> 5); scr[kk * 33 + (lane & 31)] = W[(size_t)(k0 + kk) * N + n0 + (lane & 31)]; }
    LDS_WAIT(); asm volatile("" ::: "memory");
    const int c = lane & 7;
#pragma unroll
    for (int j = 0; j < 4; ++j) { const int n = (lane >> 3) + 8 * j; const LAS float* s = scr + (8 * c) * 33 + n;
        u32x4 o; o.x = cvt_pk_bf16(s[0 * 33], s[1 * 33]); o.y = cvt_pk_bf16(s[2 * 33], s[3 * 33]); o.z = cvt_pk_bf16(s[4 * 33], s[5 * 33]); o.w = cvt_pk_bf16(s[6 * 33], s[7 * 33]);
        *(u32x4*)(WT + (size_t)(out_row0 + n) * K + k0 + 8 * c) = o; }
    LDS_WAIT(); asm volatile("" ::: "memory");
}
__device__ __forceinline__ void tr_item16(const float* W, int K, int N, bf16_t* WT, int k0, int n0, int out_row0, LAS float* scr, int lane) {
    const int c4 = (lane & 15) * 4, r4 = lane >> 4;
#pragma unroll
    for (int i = 0; i < 8; ++i) { const int kk = 4 * i + r4; *(LAS f32x4*)(scr + kk * 68 + c4) = __builtin_nontemporal_load((const f32x4*)(W + (size_t)(k0 + kk) * N + n0 + c4)); }
    LDS_WAIT(); asm volatile("" ::: "memory");
    const int kq = lane & 3;
#pragma unroll
    for (int pss = 0; pss < 4; ++pss) { const int n = (lane >> 2) + 16 * pss; const LAS float* sp = scr + (8 * kq) * 68 + n;
        u32x4 o; o.x = cvt_pk_bf16(sp[0 * 68], sp[1 * 68]); o.y = cvt_pk_bf16(sp[2 * 68], sp[3 * 68]); o.z = cvt_pk_bf16(sp[4 * 68], sp[5 * 68]); o.w = cvt_pk_bf16(sp[6 * 68], sp[7 * 68]);
        *(u32x4*)(WT + (size_t)(out_row0 + n) * K + k0 + 8 * kq) = o; }
    LDS_WAIT(); asm volatile("" ::: "memory");
}
__device__ __forceinline__ void ph_wconv_small(const Frame& F, const Params& p) {
    LAS float* scr = (LAS float*)(F.lds + F.wave * 8704);
    const int gw = F.vcu * 8 + F.wave, NGW = F.G * 8;
    constexpr int I_AIN = 16 * 64, I_AOUT = 16 * 32, I_RIN = 16 * 160, I_ROUT = 16 * 32;
    constexpr int NIT = 2 * (I_AIN + I_AOUT + I_RIN + I_ROUT);
    for (int it = gw; it < NIT; it += NGW) {
        int r = it; const int j = r & 1; r >>= 1;
        if (r < I_AIN) { const int nb = r % 64, kb = r / 64; tr_item(p.a_w_in + (size_t)j * D * 2048, D, 2048, WSP(bf16_t, WS_WAIN) + (size_t)j * 2048 * D, kb * 64, nb * 32, nb * 32, scr, F.lane); continue; } r -= I_AIN;
        if (r < I_AOUT) { const int nb = r % 32, kb = r / 32; tr_item(p.a_w_out + (size_t)j * D * D, D, D, WSP(bf16_t, WS_WAOUT) + (size_t)j * D * D, kb * 64, nb * 32, nb * 32, scr, F.lane); continue; } r -= I_AOUT;
        if (r < I_RIN) { const int nb = r % 160, kb = r / 160; tr_item(p.r_w_in + (size_t)j * D * 5120, D, 5120, WSP(bf16_t, WS_WRIN) + (size_t)j * 5120 * D, kb * 64, nb * 32, nb * 32, scr, F.lane); continue; } r -= I_RIN;
        { const int nb = r % 32, kb = r / 32; tr_item(p.r_w_out + (size_t)j * D * D, D, D, WSP(bf16_t, WS_WROUT) + (size_t)j * D * D, kb * 64, nb * 32, nb * 32, scr, F.lane); }
    }
    bf16_t* wsb = WSP(bf16_t, WS_WSB);
    for (int i = (F.vcu * 512 + F.tid) * 4; i < 2 * 8 * 128 * 128; i += F.G * 512 * 4) { const f32x4 v = *(const f32x4*)(p.a_w_s + i); u32x2 w; w.x = cvt_pk_bf16(v[0], v[1]); w.y = cvt_pk_bf16(v[2], v[3]); *(u32x2*)(wsb + i) = w; }
}
constexpr int CW_WCQ = 16384;
__device__ __forceinline__ void ph_wconv_moe(const Frame& F, const Params& p, int L) {
    LAS float* scr = (LAS float*)(F.lds + F.wave * 8704);
    const int gw = F.vcu * 8 + F.wave, NGW = F.G * 8;
    constexpr int IPM = 32 * 16;
    for (int it = gw; it < NEXP * 3 * IPM; it += NGW) {
        const int e = it / (3 * IPM), r = it % (3 * IPM), which = r / IPM, q = r % IPM, nb = q % 16, kb = q / 16, n0 = nb * 64;
        const size_t wo = ((size_t)L * NEXP + e) * D * D;
        if (which < 2) tr_item16((which == 0 ? p.moe_w_gate : p.moe_w_up) + wo, D, D, WSP(bf16_t, WS_WGU) + (size_t)e * 2048 * D, kb * 32, n0, (n0 >> 7) * 256 + (n0 & 127) + which * 128, scr, F.lane);
        else tr_item16(p.moe_w_down + wo, D, D, WSP(bf16_t, WS_WD) + (size_t)e * D * D, kb * 32, n0, n0, scr, F.lane);
    }
}
__device__ __forceinline__ float* resid_row(const Frame& F, const Params& p, int r) { return r < ROWS_L ? p.out + (size_t)r * D : WSP(float, WS_XC) + (size_t)(r - ROWS_L) * D; }
__device__ __forceinline__ int mod_row(int r) { return r < ROWS_L ? (r >> 12) : 8; }

__device__ __forceinline__ void moe_combine(const Frame& F, int r, int Lp, f32x4 (&v)[4], int myslot) {
    const bf16_t* YE = WSP(bf16_t, WS_YE); const float* MOD = WSP(float, WS_MOD); const float* GATE = WSP(float, WS_GATE);
    f32x4 s[4];
#pragma unroll
    for (int j = 0; j < 4; ++j) s[j] = (f32x4){0.f, 0.f, 0.f, 0.f};
    unsigned long long m = __ballot(myslot >= 0) & 0xffffull;
    while (m) {
        const int e0 = __builtin_ctzll(m); m &= m - 1; const bool two = m != 0ull; const int e1 = two ? __builtin_ctzll(m) : e0; if (two) m &= m - 1;
        const int s0 = __shfl(myslot, e0), s1 = __shfl(myslot, e1);
        const bf16_t* y0 = YE + ((size_t)e0 * EROWS + s0) * D + 4 * F.lane; const bf16_t* y1 = YE + ((size_t)e1 * EROWS + s1) * D + 4 * F.lane;
        const float g0 = GATE[(size_t)e0 * EROWS + s0], g1 = two ? GATE[(size_t)e1 * EROWS + s1] : 0.f;
        u32x2 w0[4], w1[4];
#pragma unroll
        for (int j = 0; j < 4; ++j) { w0[j] = *(const u32x2*)(y0 + 256 * j); w1[j] = *(const u32x2*)(y1 + 256 * j); }
#pragma unroll
        for (int j = 0; j < 4; ++j) { s[j] += (f32x4){bf_lo(w0[j].x), bf_hi(w0[j].x), bf_lo(w0[j].y), bf_hi(w0[j].y)} * g0;
            s[j] += (f32x4){bf_lo(w1[j].x), bf_hi(w1[j].x), bf_lo(w1[j].y), bf_hi(w1[j].y)} * g1; }
    }
    const float* g2 = MOD + ((size_t)Lp * 9 + mod_row(r)) * NMOD + 5 * D + 4 * F.lane;
#pragma unroll
    for (int j = 0; j < 4; ++j) v[j] += *(const f32x4*)(g2 + 256 * j) * s[j];
}
__device__ __forceinline__ void ph_t1(const Frame& F, const Params& p, int L, int nrows) {
    const int gw = F.vcu * 8 + F.wave, NGW = F.G * 8;
    const float* MOD = WSP(float, WS_MOD); bf16_t* HA = WSP(bf16_t, WS_HA); const int* slotmap = WSP(int, WS_SLOT);
    f32x4 vn[4]; int sn = -1;
#define T1_LOAD(rr) do { const float* xr_ = (L == 0 ? ((rr) < ROWS_L ? p.x + (size_t)(rr) * D : p.ctx + (size_t)((rr) - ROWS_L) * D) : (const float*)resid_row(F, p, (rr))) + 4 * F.lane; \
        _Pragma("unroll") for (int j = 0; j < 4; ++j) vn[j] = *(const f32x4*)(xr_ + 256 * j); \
        sn = -1; if (L != 0 && F.lane < 16) sn = slotmap[(size_t)(rr) * 16 + F.lane]; } while (0)
    if (gw < nrows) T1_LOAD(gw);
    for (int r = gw; r < nrows; r += NGW) {
        f32x4 v[4]; const int myslot = sn;
#pragma unroll
        for (int j = 0; j < 4; ++j) v[j] = vn[j];
        if (r + NGW < nrows) T1_LOAD(r + NGW);
        if (L != 0) { moe_combine(F, r, L - 1, v, myslot); float* xr = resid_row(F, p, r) + 4 * F.lane;
#pragma unroll
            for (int j = 0; j < 4; ++j) *(f32x4*)(xr + 256 * j) = v[j]; }
        float ss = 0.f;
#pragma unroll
        for (int j = 0; j < 4; ++j) ss += (v[j][0] * v[j][0] + v[j][1] * v[j][1]) + (v[j][2] * v[j][2] + v[j][3] * v[j][3]);
        const float rs = 1.0f / sqrtf(wave_sum(ss) * (1.0f / D) + EPS);
        const float* mp = MOD + ((size_t)L * 9 + mod_row(r)) * NMOD + 4 * F.lane; const float* gp = p.norm_mix_g + (size_t)L * D + 4 * F.lane;
        bf16_t* hr = HA + (size_t)r * D + 4 * F.lane;
#pragma unroll
        for (int j = 0; j < 4; ++j) { const f32x4 g = *(const f32x4*)(gp + 256 * j), sh = *(const f32x4*)(mp + 256 * j), sc = *(const f32x4*)(mp + D + 256 * j);
            gm::st_bf4(hr + 256 * j, (v[j] * rs * g) * (sc + 1.0f) + sh); }
    }
#undef T1_LOAD
}
__device__ __forceinline__ void ph_spatial(const Frame& F, const Params& p, int j, int nchunks) {
    const bf16_t* V = WSP(bf16_t, WS_V); const bf16_t* U = WSP(bf16_t, WS_U); bf16_t* P = WSP(bf16_t, WS_HA); const float* LNP = WSP(float, WS_VT2);
    LAS bf16_t* As = (LAS bf16_t*)F.lds; LAS bf16_t* Bs = (LAS bf16_t*)(F.lds + 128 * 272);
    const int g = F.vcu & 7;
    const int w4 = F.wave >> 1, w2 = F.wave & 1, fr = F.lane & 15, fq = F.lane >> 4;
    const int tok = F.tid >> 2, cs = F.tid & 3;
    { const bf16_t* a = WSP(bf16_t, WS_WSB) + (((size_t)j * 8 + g) * 128 + tok) * 128 + cs * 32;
#pragma unroll
      for (int q4 = 0; q4 < 4; ++q4) *(LAS u32x4*)(As + tok * 136 + cs * 32 + q4 * 8) = *(const u32x4*)(a + q4 * 8); }
    float lgv[32], lbv[32];
    { const float* lgp = p.a_ln_g + (size_t)j * D + g * 128 + cs * 32; const float* lbp = p.a_ln_b + (size_t)j * D + g * 128 + cs * 32;
#pragma unroll
      for (int q = 0; q < 8; ++q) { const f32x4 a = *(const f32x4*)(lgp + 4 * q), b = *(const f32x4*)(lbp + 4 * q);
#pragma unroll
          for (int k = 0; k < 4; ++k) { lgv[4 * q + k] = a[k]; lbv[4 * q + k] = b[k]; } } }
    float bsv[2];
#pragma unroll
    for (int mi = 0; mi < 2; ++mi) bsv[mi] = p.a_b_s[((size_t)j * 8 + g) * 128 + 32 * w4 + 16 * mi + fr];
    u32x4 vq[4]; f32x4 lp[2];
#define G2_LOAD(tt) do { const int ch_ = (tt) >> 3; const bf16_t* vr_ = V + ((size_t)ch_ * 128 + tok) * D + g * 128 + cs * 32; \
        _Pragma("unroll") for (int q4 = 0; q4 < 4; ++q4) vq[q4] = __builtin_nontemporal_load((const u32x4*)(vr_ + q4 * 8)); \
        const f32x4* pp_ = (const f32x4*)(LNP + ((size_t)ch_ * 128 + tok) * 32) + 2 * cs; lp[0] = pp_[0]; lp[1] = pp_[1]; } while (0)
    const int ntask = nchunks * 8;
    if (F.vcu < ntask) G2_LOAD(F.vcu);
    for (int t = F.vcu; t < ntask; t += F.G) {
        const int ch = t >> 3;
        float sm = (lp[0][0] + lp[0][2]) + (lp[1][0] + lp[1][2]), sq = (lp[0][1] + lp[0][3]) + (lp[1][1] + lp[1][3]);
        sm += __shfl_xor(sm, 1); sq += __shfl_xor(sq, 1); sm += __shfl_xor(sm, 2); sq += __shfl_xor(sq, 2);
        const float mean = sm * (1.0f / D), rstd = 1.0f / sqrtf(sq * (1.0f / D) - mean * mean + EPS);
#pragma unroll
        for (int q4 = 0; q4 < 4; ++q4)
#pragma unroll
            for (int k = 0; k < 4; ++k) { const int cl = q4 * 8 + k * 2;
                Bs[(cs * 32 + cl) * 136 + tok] = f2bf((bf_lo(vq[q4][k]) - mean) * rstd * lgv[cl] + lbv[cl]); Bs[(cs * 32 + cl + 1) * 136 + tok] = f2bf((bf_hi(vq[q4][k]) - mean) * rstd * lgv[cl + 1] + lbv[cl + 1]); }
        u32x2 uu[2][4];
#pragma unroll
        for (int mi = 0; mi < 2; ++mi) { const size_t ro = ((size_t)ch * 128 + 32 * w4 + 16 * mi + fr) * D + g * 128;
#pragma unroll
            for (int ni = 0; ni < 4; ++ni) uu[mi][ni] = __builtin_nontemporal_load((const u32x2*)(U + ro + 64 * w2 + 16 * ni + 4 * fq)); }
        __syncthreads();
        if (t + F.G < ntask) G2_LOAD(t + F.G);
        f32x4 acc[2][4];
#pragma unroll
        for (int mi = 0; mi < 2; ++mi)
#pragma unroll
            for (int ni = 0; ni < 4; ++ni) acc[mi][ni] = (f32x4){0.f, 0.f, 0.f, 0.f};
#pragma unroll
        for (int ks = 0; ks < 4; ++ks) { bf16x8 af[2], bfr[4];
#pragma unroll
            for (int mi = 0; mi < 2; ++mi) af[mi] = *(const LAS bf16x8*)(As + (32 * w4 + 16 * mi + fr) * 136 + ks * 32 + fq * 8);
#pragma unroll
            for (int ni = 0; ni < 4; ++ni) bfr[ni] = *(const LAS bf16x8*)(Bs + (64 * w2 + 16 * ni + fr) * 136 + ks * 32 + fq * 8);
#pragma unroll
            for (int mi = 0; mi < 2; ++mi)
#pragma unroll
                for (int ni = 0; ni < 4; ++ni) acc[mi][ni] = __builtin_amdgcn_mfma_f32_16x16x32_bf16(bfr[ni], af[mi], acc[mi][ni], 0, 0, 0); }
#pragma unroll
        for (int mi = 0; mi < 2; ++mi) { const size_t ro = ((size_t)ch * 128 + 32 * w4 + 16 * mi + fr) * D + g * 128;
#pragma unroll
            for (int ni = 0; ni < 4; ++ni) { const int d0 = 64 * w2 + 16 * ni + 4 * fq; const u32x2 u2 = uu[mi][ni]; const f32x4 sv = acc[mi][ni] + bsv[mi];
                gm::st_bf4(P + ro + d0, (f32x4){bf_lo(u2.x) * sv[0], bf_hi(u2.x) * sv[1], bf_lo(u2.y) * sv[2], bf_hi(u2.y) * sv[3]}); } }
        __syncthreads();
    }
#undef G2_LOAD
}
__device__ __forceinline__ void ph_prefix(const Frame& F, const Params& p, int j) {
    const bf16_t* UT = WSP(bf16_t, WS_UT); bf16_t* ST = WSP(bf16_t, WS_ST); const float* logg = WSP(float, WS_LOGG) + j * 8;
#define UT_LD(o_) ({ const u32x2 w_ = __builtin_nontemporal_load((const u32x2*)(UT + (o_))); (f32x4){bf_lo(w_.x), bf_hi(w_.x), bf_lo(w_.y), bf_hi(w_.y)}; })
    const int nq = 32 * 2 * (int)(PBLK / 4);
    for (int q = F.vcu * 512 + F.tid; q < nq; q += F.G * 512) {
        const int e4 = q & (int)(PBLK / 4 - 1), dir = (q >> 14) & 1, bh = q >> 15;
        const float dec = fexp2(logg[dir * 4 + (bh & 3)] * (float)SCH);
        f32x4 S = UT_LD((size_t)((bh * 9 + 8) * 2 + dir) * PBLK + e4 * 4);
        gm::st_bf4(ST + (size_t)((bh * 9 + 8) * 2 + dir) * PBLK + e4 * 4, (f32x4){0.f, 0.f, 0.f, 0.f});
        for (int s = 0; s < NX; ++s) { const int X = dir ? (NX - 1 - s) : s; const size_t o = (size_t)((bh * 9 + X) * 2 + dir) * PBLK + e4 * 4;
            gm::st_bf4(ST + o, S); S = S * dec + UT_LD(o); }
    }
#undef UT_LD
}
__device__ __forceinline__ float half_sum(float v) {
#pragma unroll
    for (int o = 1; o < 32; o <<= 1) v += __shfl_xor(v, o);
    return v;
}
__device__ __forceinline__ void ph_headnorm(const Frame& F, int nrows) {
    const int gw = F.vcu * 8 + F.wave, NGW = F.G * 8;
    const bf16_t* OF = WSP(bf16_t, WS_OF); const bf16_t* OB = WSP(bf16_t, WS_OB); const bf16_t* GF = WSP(bf16_t, WS_GF); const bf16_t* GB = WSP(bf16_t, WS_GB); bf16_t* YR = WSP(bf16_t, WS_HA);
    u32x4 wn[2][2], gqn[2][2];
#define HN_LOAD(rr) do { const size_t o_ = (size_t)(rr) * D + 8 * F.lane; _Pragma("unroll") for (int k = 0; k < 2; ++k) _Pragma("unroll") for (int dir = 0; dir < 2; ++dir) { \
        wn[k][dir] = *(const u32x4*)((dir ? OB : OF) + o_ + 512 * k); gqn[k][dir] = *(const u32x4*)((dir ? GB : GF) + o_ + 512 * k); } } while (0)
    if (gw < nrows) HN_LOAD(gw);
    for (int r = gw; r < nrows; r += NGW) { const size_t o = (size_t)r * D + 8 * F.lane;
        u32x4 wc_[2][2], gc_[2][2];
#pragma unroll
        for (int k = 0; k < 2; ++k)
#pragma unroll
            for (int dir = 0; dir < 2; ++dir) { wc_[k][dir] = wn[k][dir]; gc_[k][dir] = gqn[k][dir]; }
        if (r + NGW < nrows) HN_LOAD(r + NGW);
#pragma unroll
        for (int k = 0; k < 2; ++k) { float y[8];
#pragma unroll
            for (int q = 0; q < 8; ++q) y[q] = 0.f;
#pragma unroll
            for (int dir = 0; dir < 2; ++dir) { const u32x4 w = wc_[k][dir], gq = gc_[k][dir];
                float v[8], g[8];
#pragma unroll
                for (int q = 0; q < 4; ++q) { v[2 * q] = bf_lo(w[q]); v[2 * q + 1] = bf_hi(w[q]); g[2 * q] = bf_lo(gq[q]); g[2 * q + 1] = bf_hi(gq[q]); }
                const float mean = half_sum(((v[0] + v[1]) + (v[2] + v[3])) + ((v[4] + v[5]) + (v[6] + v[7]))) * (1.0f / DH); float sq = 0.f;
#pragma unroll
                for (int q = 0; q < 8; ++q) { v[q] -= mean; sq += v[q] * v[q]; }
                const float rstd = 1.0f / sqrtf(half_sum(sq) * (1.0f / DH) + EPS);
#pragma unroll
                for (int q = 0; q < 8; ++q) y[q] += g[q] * v[q] * rstd; }
            u32x4 ow; ow.x = cvt_pk_bf16(y[0], y[1]); ow.y = cvt_pk_bf16(y[2], y[3]); ow.z = cvt_pk_bf16(y[4], y[5]); ow.w = cvt_pk_bf16(y[6], y[7]);
            *(u32x4*)(YR + o + 512 * k) = ow; } }
#undef HN_LOAD
}
__device__ __forceinline__ void rt_fill(const Frame& F, const Params& p, int L) {
    LAS float* wt = (LAS float*)F.lds;
    for (int i = F.tid * 4; i < D * NEXP; i += 512 * 4) { const f32x4 w = *(const f32x4*)(p.moe_w_router + (size_t)L * D * NEXP + i); const int k = i >> 4, e0 = i & 15;
        wt[(e0 + 0) * D + k] = w[0]; wt[(e0 + 1) * D + k] = w[1]; wt[(e0 + 2) * D + k] = w[2]; wt[(e0 + 3) * D + k] = w[3]; }
    __syncthreads();
}
template <int NR>
__device__ __forceinline__ void rt_rows(const Frame& F, const Params& p, int L, int rbase, int rfirst, int rstride, int cnt) {
    LAS float* wt = (LAS float*)F.lds;
    const float* MOD = WSP(float, WS_MOD); bf16_t* HA = WSP(bf16_t, WS_HA); float* AFF = WSP(float, WS_AFF);
    const int gw = rbase + rfirst, NGW = rstride, nrows = rbase + rfirst + rstride * cnt;
    f32x4 vn[NR][4];
#define RT_LOAD(rz) do { _Pragma("unroll") for (int q = 0; q < NR; ++q) { const int rq_ = (rz) + q * NGW; const float* xq_ = resid_row(F, p, rq_ < nrows ? rq_ : (rz)) + 4 * F.lane; \
        _Pragma("unroll") for (int j = 0; j < 4; ++j) vn[q][j] = *(const f32x4*)(xq_ + 256 * j); } } while (0)
    if (gw < nrows) RT_LOAD(gw);
    for (int r0 = gw; r0 < nrows; r0 += NR * NGW) {
        int rr[NR]; bool ok[NR];
#pragma unroll
        for (int q = 0; q < NR; ++q) { const int rq = r0 + q * NGW; ok[q] = rq < nrows; rr[q] = ok[q] ? rq : r0; }
        f32x4 v[NR][4]; float lg[NR][16];
#pragma unroll
        for (int q = 0; q < NR; ++q)
#pragma unroll
            for (int j = 0; j < 4; ++j) v[q][j] = vn[q][j];
        { const int n0 = r0 + NR * NGW; if (n0 < nrows) RT_LOAD(n0); }
#pragma unroll
        for (int q = 0; q < NR; ++q) { float ss = 0.f;
#pragma unroll
            for (int j = 0; j < 4; ++j) ss += (v[q][j][0] * v[q][j][0] + v[q][j][1] * v[q][j][1]) + (v[q][j][2] * v[q][j][2] + v[q][j][3] * v[q][j][3]);
            const float rs = 1.0f / sqrtf(wave_sum(ss) * (1.0f / D) + EPS);
            const float* mp = MOD + ((size_t)L * 9 + mod_row(rr[q])) * NMOD + 3 * D + 4 * F.lane; const float* gp = p.norm_ffn_g + (size_t)L * D + 4 * F.lane;
            bf16_t* hr = HA + (size_t)rr[q] * D + 4 * F.lane;
#pragma unroll
            for (int j = 0; j < 4; ++j) { const f32x4 g = *(const f32x4*)(gp + 256 * j), sh = *(const f32x4*)(mp + 256 * j), sc = *(const f32x4*)(mp + D + 256 * j);
                v[q][j] = (v[q][j] * rs * g) * (sc + 1.0f) + sh; if (ok[q]) gm::st_bf4(hr + 256 * j, v[q][j]); } }
#pragma unroll
        for (int e = 0; e < 16; ++e) { f32x2 a[NR];
#pragma unroll
            for (int q = 0; q < NR; ++q) a[q] = (f32x2){0.f, 0.f};
#pragma unroll
            for (int j = 0; j < 4; ++j) { const f32x4 w = *(const LAS f32x4*)(wt + e * D + 4 * F.lane + 256 * j); const f32x2 wl = (f32x2){w[0], w[1]}, wh = (f32x2){w[2], w[3]};
#pragma unroll
                for (int q = 0; q < NR; ++q) { a[q] += (f32x2){v[q][j][0], v[q][j][1]} * wl; a[q] += (f32x2){v[q][j][2], v[q][j][3]} * wh; } }
#pragma unroll
            for (int q = 0; q < NR; ++q) lg[q][e] = a[q].x + a[q].y; }
        float lgt[NR];
#pragma unroll
        for (int q = 0; q < NR; ++q) {
#pragma unroll
            for (int i = 0; i < 8; ++i) { const bool up = (F.lane & 32) != 0; const float keep = up ? lg[q][i + 8] : lg[q][i], send = up ? lg[q][i] : lg[q][i + 8]; lg[q][i] = keep + __shfl_xor(send, 32); }
#pragma unroll
            for (int i = 0; i < 4; ++i) { const bool up = (F.lane & 16) != 0; const float keep = up ? lg[q][i + 4] : lg[q][i], send = up ? lg[q][i] : lg[q][i + 4]; lg[q][i] = keep + __shfl_xor(send, 16); }
#pragma unroll
            for (int i = 0; i < 2; ++i) { const bool up = (F.lane & 8) != 0; const float keep = up ? lg[q][i + 2] : lg[q][i], send = up ? lg[q][i] : lg[q][i + 2]; lg[q][i] = keep + __shfl_xor(send, 8); }
            { const bool up = (F.lane & 4) != 0; const float keep = up ? lg[q][1] : lg[q][0], send = up ? lg[q][0] : lg[q][1]; lg[q][0] = keep + __shfl_xor(send, 4); }
            float t = lg[q][0]; t += __shfl_xor(t, 2); t += __shfl_xor(t, 1); lgt[q] = t; }
#pragma unroll
        for (int q = 0; q < NR; ++q) { float mx = lgt[q];
#pragma unroll
            for (int o = 4; o < 64; o <<= 1) mx = fmaxf(mx, __shfl_xor(mx, o));
            const float pe = __expf(lgt[q] - mx); float den = pe;
#pragma unroll
            for (int o = 4; o < 64; o <<= 1) den += __shfl_xor(den, o);
            if ((F.lane & 3) == 0 && ok[q]) { const float a = pe / den; const int e = F.lane >> 2, r = rr[q];
                if (r < ROWS_L) AFF[((size_t)(r >> 12) * 16 + e) * SEQ + (r & (SEQ - 1))] = a;
                else { const int rc = r - ROWS_L; AFF[(size_t)128 * SEQ + ((size_t)(rc >> 8) * 16 + e) * CTXL + (rc & (CTXL - 1))] = a; } } }
    }
#undef RT_LOAD
}
__device__ __forceinline__ void ph_topk(const Frame& F, int ntasks) {
    LAS unsigned* keys = (LAS unsigned*)F.lds;
    LAS unsigned* hist = (LAS unsigned*)(F.lds + 16384);
    LAS unsigned* misc = (LAS unsigned*)(F.lds + 16384 + 1024);
    const float* AFF = WSP(float, WS_AFF); int* IDX = WSP(int, WS_IDX); float* GATE = WSP(float, WS_GATE); int* SLOT = WSP(int, WS_SLOT);
    for (int task = F.vcu; task < ntasks; task += F.G) {
        const bool lat = task < 128; const int be = lat ? task : task - 128, b = be >> 4, e = be & 15;
        const int n = lat ? SEQ : CTXL, cap = lat ? CAP_L : CAP_C;
        const float* src = AFF + (lat ? (size_t)be * SEQ : (size_t)128 * SEQ + (size_t)be * CTXL);
        for (int i = F.tid; i < n; i += 512) keys[i] = __builtin_bit_cast(unsigned, src[i]);
        if (F.tid == 0) { misc[0] = 0u; misc[1] = (unsigned)cap; }
        __syncthreads();
        unsigned mask = 0u;
        for (int pass = 0; pass < 4; ++pass) { const int shift = 24 - 8 * pass;
            if (F.tid < 256) hist[F.tid] = 0u;
            __syncthreads();
            const unsigned prefix = misc[0];
            for (int i = F.tid; i < n; i += 512) { const unsigned k = keys[i]; if ((k & mask) == prefix) __hip_atomic_fetch_add(&hist[(k >> shift) & 255u], 1u, __ATOMIC_RELAXED, __HIP_MEMORY_SCOPE_WORKGROUP); }
            __syncthreads();
            if (F.wave == 0) {
                const unsigned need = misc[1]; const u32x4 hc = *(const LAS u32x4*)(hist + 4 * F.lane); const unsigned sl = (hc[0] + hc[1]) + (hc[2] + hc[3]);
                unsigned suf = sl;
#pragma unroll
                for (int o = 1; o < 64; o <<= 1) { const unsigned t = __shfl_down(suf, o); if (F.lane + o < 64) suf += t; }
                const unsigned above = suf - sl;
                if (above < need && need <= above + sl) {
                    const unsigned c3 = above, c2 = c3 + hc[3], c1 = c2 + hc[2], c0 = c1 + hc[1];
                    const int d = (c3 + hc[3] >= need) ? 3 : (c2 + hc[2] >= need) ? 2 : (c1 + hc[1] >= need) ? 1 : 0;
                    const unsigned cum = d == 3 ? c3 : d == 2 ? c2 : d == 1 ? c1 : c0;
                    misc[0] = prefix | ((unsigned)(4 * F.lane + d) << shift); misc[1] = need - cum; } }
            mask |= 255u << shift;
            __syncthreads();
        }
        const unsigned T = misc[0], need_eq = misc[1];
        const int i0 = F.tid * 8; unsigned cg = 0u, ce = 0u; unsigned kk[8];
#pragma unroll
        for (int q = 0; q < 8; ++q) { const int i = i0 + q; kk[q] = (i < n) ? keys[i] : 0u; cg += (i < n && kk[q] > T) ? 1u : 0u; ce += (i < n && kk[q] == T) ? 1u : 0u; }
        unsigned pk = cg | (ce << 16), incl = pk;
#pragma unroll
        for (int o = 1; o < 64; o <<= 1) { const unsigned t = __shfl_up(incl, o); if (F.lane >= o) incl += t; }
        if (F.lane == 63) misc[8 + F.wave] = incl;
        __syncthreads();
        unsigned wbase = 0u;
#pragma unroll
        for (int w = 0; w < 8; ++w) wbase += (w < F.wave) ? misc[8 + w] : 0u;
        const unsigned excl = wbase + incl - pk; unsigned ng = excl & 0xffffu, ne = excl >> 16;
        const int slotbase = lat ? b * CAP_L : NB * CAP_L + b * CAP_C; const int rowbase = lat ? b * SEQ : ROWS_L + b * CTXL;
#pragma unroll
        for (int q = 0; q < 8; ++q) { const int i = i0 + q; if (i < n) {
                const bool gt = kk[q] > T, eq = kk[q] == T; const bool sel = gt || (eq && ne < need_eq);
                const int slot = slotbase + (int)(ng + (ne < need_eq ? ne : need_eq));
                if (sel) { IDX[e * EROWS + slot] = rowbase + i; GATE[e * EROWS + slot] = __builtin_bit_cast(float, kk[q]); }
                SLOT[(size_t)(rowbase + i) * 16 + e] = sel ? slot : -1;
                ng += gt ? 1u : 0u; ne += eq ? 1u : 0u; } }
        __syncthreads();
    }
}
__device__ __forceinline__ void ph_final(const Frame& F, const Params& p) {
    const int gw = F.vcu * 8 + F.wave, NGW = F.G * 8; const int* slotmap = WSP(int, WS_SLOT);
    f32x4 vn[4]; int sn = -1;
#define FN_LOAD(rr) do { const float* xr_ = p.out + (size_t)(rr) * D + 4 * F.lane; \
        _Pragma("unroll") for (int j = 0; j < 4; ++j) vn[j] = *(const f32x4*)(xr_ + 256 * j); \
        sn = -1; if (F.lane < 16) sn = slotmap[(size_t)(rr) * 16 + F.lane]; } while (0)
    if (gw < ROWS_L) FN_LOAD(gw);
    for (int r = gw; r < ROWS_L; r += NGW) { float* xr = p.out + (size_t)r * D + 4 * F.lane; f32x4 v[4]; const int myslot = sn;
#pragma unroll
        for (int j = 0; j < 4; ++j) v[j] = vn[j];
        if (r + NGW < ROWS_L) FN_LOAD(r + NGW);
        moe_combine(F, r, DEPTH - 1, v, myslot);
        float ss = 0.f;
#pragma unroll
        for (int j = 0; j < 4; ++j) ss += (v[j][0] * v[j][0] + v[j][1] * v[j][1]) + (v[j][2] * v[j][2] + v[j][3] * v[j][3]);
        const float rs = 1.0f / sqrtf(wave_sum(ss) * (1.0f / D) + EPS);
#pragma unroll
        for (int j = 0; j < 4; ++j) *(f32x4*)(xr + 256 * j) = v[j] * rs * *(const f32x4*)(p.final_norm_g + 4 * F.lane + 256 * j); }
#undef FN_LOAD
}

constexpr int CW_HND = 8192;
__device__ __forceinline__ void handoff_publish(const Frame& F, unsigned* ctr) {
    asm volatile("s_waitcnt vmcnt(0)" ::: "memory"); __syncthreads();
    if (F.tid == 0) { __builtin_amdgcn_fence(__ATOMIC_RELEASE, "agent"); asm volatile("s_waitcnt vmcnt(0)" ::: "memory"); (void)__hip_atomic_fetch_add(ctr, 1u, __ATOMIC_RELAXED, __HIP_MEMORY_SCOPE_AGENT); }
}
__device__ __forceinline__ void handoff_wait(const Frame& F, unsigned* ctr, unsigned need) {
    if (F.tid == 0) { unsigned sp = 0;
        while (__hip_atomic_load(ctr, __ATOMIC_RELAXED, __HIP_MEMORY_SCOPE_AGENT) < need) { __builtin_amdgcn_s_sleep(2); if (++sp > (1u << 20)) break; }
        __builtin_amdgcn_fence(__ATOMIC_ACQUIRE, "agent"); asm volatile("s_waitcnt vmcnt(0)" ::: "memory"); }
    __syncthreads();
}
constexpr int PH_PER_LAYER = 16, PH_FINAL = 1 + PH_PER_LAYER * DEPTH, PH_TOTAL = PH_FINAL + 1;

#ifdef PROBE_SITE
#ifndef PROBE_K
#define PROBE_K 8
#endif
#define PB(s) unsigned long long pt0_ = 0ull; if ((s) == PROBE_SITE) pt0_ = __builtin_amdgcn_s_memrealtime()
#define PE(s) if ((s) == PROBE_SITE) probe_acc += __builtin_amdgcn_s_memrealtime() - pt0_
#else
#define PB(s) do {} while (0)
#define PE(s) do {} while (0)
#endif
template <int ONLY> __global__ void __launch_bounds__(512, 2) mk_fwd(Params p) {
    extern __shared__ __attribute__((aligned(16))) unsigned char lds_raw[];
    Frame F0; frame_init(F0, (LAS unsigned char*)lds_raw);
    volatile LAS unsigned* MISC = (volatile LAS unsigned*)(F0.lds + MISC_OFF);
    if (F0.tid < 32) MISC[F0.tid] = 0u;
    __syncthreads();
#if MK_SINGLE
    XcdBarrier bar = xcd_barrier_post((unsigned*)(p.ws + WS_CTL) + CW_BAR, MISC + 8);
#define SEAM() do { XcdBarrier b_ = bar; asm volatile("" : "+s"(b_.bar)); xcd_barrier(b_); } while (0)
#else
#define SEAM() do {} while (0)
#endif
#ifdef PROBE_SITE
    unsigned long long probe_acc = 0ull;
#endif
    const int lo = p.ph_lo, hi = p.ph_hi;
#define IN(k) (lo <= (k) && (k) < hi)
#ifdef ONLY_SITE
#define SITE(s) ((s) == ONLY_SITE && (ONLY < 0 || (s) == ONLY))
#else
#define SITE(s) (ONLY < 0 || (s) == ONLY)
#endif
#define SITE_ENTER() KParams pp_ = (KParams)__builtin_amdgcn_kernarg_segment_ptr(); asm volatile("" : "+s"(pp_)); Params P; load_params(P, pp_); Frame F; frame_init(F, (LAS unsigned char*)lds_raw); F.ws = P.ws; const int c = F.bx; (void)c

    if (SITE(0) && IN(0)) { SITE_ENTER(); PB(0); ph_mod(F, P); ph_tables(F, P); ph_wconv_small(F, P); SEAM(); PE(0); }

#pragma unroll 1
    for (int L = 0; L < DEPTH; ++L) {
        const int base = 1 + PH_PER_LAYER * L, j = L >> 1; const bool last = (L == DEPTH - 1), kind1 = (L & 1) != 0;
        if (SITE(1) && IN(base + 0)) { SITE_ENTER(); PB(1); ph_wconv_moe(F, P, L); ph_t1(F, P, L, ROWS); SEAM(); PE(1); }
        if (!kind1) {
            if (SITE(2) && IN(base + 1)) {
                SITE_ENTER(); PB(2);
                gm::SchedG S{nullptr, (const char*)WSP(bf16_t, WS_HA), (const char*)(WSP(bf16_t, WS_WAIN) + (size_t)j * 2048 * D), 2048u, 2048u, 16, ROWS / 256, 8, 0, 0, 0, 0, ROWS / 256, ROWS / 256, 0, F.G, c};
                gm::EpiGelu E{WSP(bf16_t, WS_U), WSP(bf16_t, WS_V), WSP(float, WS_VT2)};
                gm::gemm_units(F.lds, F.tid, S, E); SEAM(); PE(2); }
            if (SITE(4) && IN(base + 3)) { SITE_ENTER(); PB(4); ph_spatial(F, P, j, ROWS / 128); SEAM(); PE(4); }
            if (SITE(5) && IN(base + 4)) {
                SITE_ENTER(); PB(5);
                gm::SchedG S{nullptr, (const char*)WSP(bf16_t, WS_HA), (const char*)(WSP(bf16_t, WS_WAOUT) + (size_t)j * D * D), 2048u, 2048u, 16, 128, 4, 0, 0, 0, 0, ROWS / 256, ROWS / 256, 0, F.G, c};
                gm::EpiRes E{(L == 0) ? P.x : P.out, (L == 0) ? P.ctx : WSP(float, WS_XC), P.out, WSP(float, WS_XC), WSP(float, WS_MOD) + (size_t)L * 9 * NMOD + 2 * D};
                gm::gemm_units(F.lds, F.tid, S, E); SEAM(); PE(5); }
        } else {
            if (SITE(6) && IN(base + 1)) {
                SITE_ENTER(); PB(6);
                gm::SchedG S{nullptr, (const char*)WSP(bf16_t, WS_HA), (const char*)(WSP(bf16_t, WS_WRIN) + (size_t)j * 5120 * D), 2048u, 2048u, 16, 128, 20, 0, 0, 0, 0, ROWS / 256, ROWS / 256, 0, F.G, c};
                gm::EpiRetIn E{WSP(bf16_t, WS_Q), WSP(bf16_t, WS_K), WSP(bf16_t, WS_KFT), WSP(bf16_t, WS_KBT), WSP(bf16_t, WS_VT), WSP(bf16_t, WS_GF), WSP(bf16_t, WS_GB), WSP(float, WS_ROPE), WSP(float, WS_LOGG) + j * 8, F.lds};
                gm::gemm_units(F.lds, F.tid, S, E); SEAM(); PE(6); }
            if (SITE(7) && IN(base + 2)) {
                SITE_ENTER(); PB(7);
                const int nn2 = last ? 8 : 20, nu1 = 8 * nn2;
                unsigned* cb = (unsigned*)(F.ws + WS_CTL) + CW_HND + (32 + L * 8) * 64;
                { gm::SchedG S{nullptr, (const char*)WSP(bf16_t, WS_HA), (const char*)(WSP(bf16_t, WS_WRIN) + (size_t)j * 5120 * D), 2048u, 2048u, 16, 0, 20, 8, nn2, 128, last ? 4 : 0, ROWS / 256, ROWS / 256, 0, F.G, c};
                  gm::EpiRetIn E{WSP(bf16_t, WS_Q), WSP(bf16_t, WS_K), WSP(bf16_t, WS_KFT), WSP(bf16_t, WS_KBT), WSP(bf16_t, WS_VT), WSP(bf16_t, WS_GF), WSP(bf16_t, WS_GB), WSP(float, WS_ROPE), WSP(float, WS_LOGG) + j * 8, F.lds};
                  gm::gemm_units(F.lds, F.tid, S, E);
                  if (c < nu1) { int pmc, pnc; gm::tile_order(c, 8, nn2, pmc, pnc); handoff_publish(F, cb + pmc * 64); } }
                { gm::SchedState S{(const char*)WSP(bf16_t, WS_VT), (const char*)WSP(bf16_t, WS_KFT), (const char*)WSP(bf16_t, WS_KBT), (unsigned)TOK * 2u, (unsigned)TOK * 2u, F.G, c, 0, 512, 0};
                  gm::EpiBlk E{WSP(bf16_t, WS_UT)};
                  gm::gemm_units(F.lds, F.tid, S, E); }
                if (c >= nu1 && c < nu1 + 64) { const int Lc = 512 + (c - nu1), q = ((Lc >> 3) >> 1) * 8 + (Lc & 7), bhc = q - 256; handoff_wait(F, cb + (bhc >> 2) * 64, (unsigned)nn2); }
                { gm::SchedState S{(const char*)WSP(bf16_t, WS_VT), (const char*)WSP(bf16_t, WS_KFT), (const char*)WSP(bf16_t, WS_KBT), (unsigned)TOK * 2u, (unsigned)TOK * 2u, F.G, c, 512, 64, nu1};
                  gm::EpiBlk E{WSP(bf16_t, WS_UT)};
                  gm::gemm_units(F.lds, F.tid, S, E); }
                SEAM(); PE(7); }
            if (SITE(9) && IN(base + 4)) {
                SITE_ENTER(); PB(9);
                gm::SchedAtt S{(const char*)WSP(bf16_t, WS_Q), (const char*)WSP(bf16_t, WS_K), 2048u, 2048u, 32 * NX * 4, last ? 0 : 32, F.G, c};
                gm::EpiAtt E{WSP(bf16_t, WS_PF), WSP(bf16_t, WS_PB), WSP(float, WS_LOGG) + j * 8};
                gm::gemm_units(F.lds, F.tid, S, E); ph_prefix(F, P, j); SEAM(); PE(9); }
            if (SITE(10) && IN(base + 5)) {
                SITE_ENTER(); PB(10);
                gm::SchedOut S{(const char*)WSP(bf16_t, WS_Q), (const char*)WSP(bf16_t, WS_ST), (const char*)WSP(bf16_t, WS_PF), (const char*)WSP(bf16_t, WS_PB), (const char*)WSP(bf16_t, WS_VT),
                               2048u, 512u, 512u, (unsigned)TOK * 2u, 4, 32 * NX * 4, last ? 0 : 64, F.G, c};
                gm::EpiOut E{WSP(bf16_t, WS_OF), WSP(bf16_t, WS_OB), WSP(float, WS_LOGG) + j * 8};
                gm::gemm_units(F.lds, F.tid, S, E); SEAM(); PE(10); }
            if (SITE(11) && IN(base + 6)) { SITE_ENTER(); PB(11); ph_headnorm(F, last ? ROWS_L : ROWS); SEAM(); PE(11); }
            if (SITE(12) && IN(base + 7)) {
                SITE_ENTER(); PB(12);
                const int nM = 128;
                gm::SchedG S{nullptr, (const char*)WSP(bf16_t, WS_HA), (const char*)(WSP(bf16_t, WS_WROUT) + (size_t)j * D * D), 2048u, 2048u, 16, nM, 4, 0, 0, 0, 0, ROWS / 256, ROWS / 256, 0, F.G, c};
                gm::EpiRes E{P.out, WSP(float, WS_XC), P.out, WSP(float, WS_XC), WSP(float, WS_MOD) + (size_t)L * 9 * NMOD + 2 * D};
                gm::gemm_units(F.lds, F.tid, S, E); SEAM(); PE(12); }
        }
        if (SITE(13) && IN(base + 8)) { SITE_ENTER(); PB(13);
            const bool cx = !last; const bool light = cx && c < 32; int tile = 0, quarter = 0;
            unsigned* ctr = (unsigned*)(F.ws + WS_CTL) + CW_HND;
            if (cx) {
                gm::SchedG S{nullptr, (const char*)WSP(bf16_t, WS_HA), (const char*)((kind1 ? WSP(bf16_t, WS_WROUT) : WSP(bf16_t, WS_WAOUT)) + (size_t)j * D * D), 2048u, 2048u, 16, 0, 4, 8, 4, 128, 0, ROWS / 256, ROWS / 256, 0, F.G, c};
                gm::EpiRes E{(L == 0) ? P.x : P.out, (L == 0) ? P.ctx : WSP(float, WS_XC), P.out, WSP(float, WS_XC), WSP(float, WS_MOD) + (size_t)L * 9 * NMOD + 2 * D};
                gm::gemm_units(F.lds, F.tid, S, E);
                if (light) { gm::tile_order(c, 8, 4, tile, quarter); ctr += (L * 8 + tile) * 64; handoff_publish(F, ctr); }
            }
            if (!light) rt_fill(F, P, L);
            if (!cx) rt_rows<4>(F, P, L, 0, F.vcu * 8 + F.wave, F.G * 8, ROWS_L / (F.G * 8));
            else if (!light) {
                const int fw = (c - 32) * 8 + F.wave, nfw = (F.G - 32) * 8; rt_rows<4>(F, P, L, 0, fw, nfw, (ROWS_L - fw + nfw - 1) / nfw);
                if (F.tid == 0) { unsigned* cb = (unsigned*)(F.ws + WS_CTL) + CW_HND + (L * 8) * 64;
                    for (int t8 = 0; t8 < 8; ++t8) { unsigned sp = 0; while (__hip_atomic_load(cb + t8 * 64, __ATOMIC_RELAXED, __HIP_MEMORY_SCOPE_AGENT) < 4u) { __builtin_amdgcn_s_sleep(2); if (++sp > (1u << 20)) break; } }
                    __builtin_amdgcn_fence(__ATOMIC_ACQUIRE, "agent"); asm volatile("s_waitcnt vmcnt(0)" ::: "memory"); }
                __syncthreads();
                rt_rows<4>(F, P, L, ROWS_L, fw, nfw, (ROWS_C - fw + nfw - 1) / nfw);
            }
            SEAM(); PE(13); }
        if (SITE(14) && IN(base + 9)) { SITE_ENTER(); PB(14); ph_topk(F, last ? 128 : 256); SEAM(); PE(14); }
        {
            const int tpe = last ? 16 : 17;
            if (SITE(16) && IN(base + 11)) {
                SITE_ENTER(); PB(16);
                gm::SchedGT<true> S{WSP(int, WS_IDX), (const char*)WSP(bf16_t, WS_HA), (const char*)WSP(bf16_t, WS_WGU), 2048u, 2048u, 16, NEXP * tpe, 8, 0, 0, 0, 0, tpe, 17, (size_t)2048 * D * 2, F.G, c};
                gm::EpiSwiglu E{WSP(bf16_t, WS_HID)};
                gm::gemm_units(F.lds, F.tid, S, E); SEAM(); PE(16); }
            if (SITE(17) && IN(base + 12)) {
                SITE_ENTER(); PB(17);
                gm::SchedG S{nullptr, (const char*)WSP(bf16_t, WS_HID), (const char*)WSP(bf16_t, WS_WD), 2048u, 2048u, 16, NEXP * tpe, 4, 0, 0, 0, 0, tpe, 17, (size_t)D * D * 2, F.G, c};
                gm::EpiDown E{WSP(bf16_t, WS_YE), WSP(float, WS_GATE)};
                gm::gemm_units(F.lds, F.tid, S, E); SEAM(); PE(17); }
        }
    }
    if (SITE(18) && IN(PH_FINAL)) { SITE_ENTER(); PB(18); ph_final(F, P); PE(18); }
#ifdef PROBE_SITE
    if (blockIdx.x == 0 && threadIdx.x == 0) { const unsigned long long t0 = __builtin_amdgcn_s_memrealtime(), w = probe_acc * PROBE_K; while (__builtin_amdgcn_s_memrealtime() - t0 < w) __builtin_amdgcn_s_sleep(16); }
#endif
#undef IN
#undef SEAM
#undef SITE
#undef SITE_ENTER
}

extern "C" void kernel_launch(void* const* d_in, const int* in_sizes, int n_in, void* d_out, int out_size, void* d_ws, size_t ws_size, hipStream_t stream) {
    static int grid = 0;
    if (grid == 0) {
        if (n_in != 23 || ws_size < WS_END) { fprintf(stderr, "kernel_launch: n_in %d ws %zu (need %zu)\n", n_in, ws_size, (size_t)WS_END); grid = -1; return; }
        int dev = 0, cus = 0;
        if (hipGetDevice(&dev) != hipSuccess || hipDeviceGetAttribute(&cus, hipDeviceAttributeMultiprocessorCount, dev) != hipSuccess) { grid = -1; return; }
        if (hipFuncSetAttribute((const void*)mk_fwd<-1>, hipFuncAttributeMaxDynamicSharedMemorySize, LDS_BYTES) != hipSuccess) { grid = -1; return; }
        (void)hipGetLastError();
        grid = cus & ~7;
    }
    if (grid < 0) return;
    (void)hipMemsetAsync((char*)d_ws + WS_CTL, 0, CTL_ZERO_BYTES, stream);
    Params p{};
    const float** ins = (const float**)&p;
    for (int i = 0; i < 23; ++i) ins[i] = (const float*)d_in[i];
    p.out = (float*)d_out; p.ws = (unsigned char*)d_ws;
    p.ph_lo = 0; p.ph_hi = PH_TOTAL;
    hipLaunchKernelGGL(mk_fwd<-1>, dim3(grid), dim3(512), LDS_BYTES, stream, p);
}
```

```cpp
#include <hip/hip_runtime.h>
#include <cstdio>
#include <cstdint>

#ifndef MK_SINGLE
#define MK_SINGLE 1
#endif

#define LAS __attribute__((address_space(3)))
#define GAS __attribute__((address_space(1)))
typedef unsigned short bf16_t;
typedef short bf16x8 __attribute__((ext_vector_type(8)));
typedef float f32x4 __attribute__((ext_vector_type(4)));
typedef float f32x2 __attribute__((ext_vector_type(2)));
typedef unsigned u32x4 __attribute__((ext_vector_type(4)));
typedef unsigned u32x2 __attribute__((ext_vector_type(2)));

constexpr int D = 1024, NB = 8, SEQ = 4096, CTXL = 256, DEPTH = 4;
constexpr int ROWS_L = NB * SEQ, ROWS_C = NB * CTXL, ROWS = ROWS_L + ROWS_C;
constexpr int NEXP = 16, CAP_L = 512, CAP_C = 32, EROWS = NB * CAP_L + NB * CAP_C;
constexpr int TOK = SEQ + CTXL;
constexpr int NH = 4, DH = 256, SCH = 512, NX = SEQ / SCH;
constexpr float EPS = 1e-6f;
constexpr int NMOD = 6 * D;

constexpr size_t MiB = 1u << 20;
constexpr size_t WS_CTL = 0, CTL_ZERO_BYTES = 65536;
constexpr size_t WS_MOD = 1 * MiB;
constexpr size_t WS_ROPE = 2 * MiB;
constexpr size_t WS_LOGG = 2 * MiB + 65536;
constexpr size_t WS_XC = 3 * MiB;
constexpr size_t WS_AFF = 11 * MiB;
constexpr size_t WS_SLOT = 14 * MiB;
constexpr size_t WS_IDX = 17 * MiB;
constexpr size_t WS_GATE = 17 * MiB + 512 * 1024;
constexpr size_t WS_WAIN = 18 * MiB;
constexpr size_t WS_WAOUT = 26 * MiB;
constexpr size_t WS_WRIN = 30 * MiB;
constexpr size_t WS_WROUT = 50 * MiB;
constexpr size_t WS_WSB = 54 * MiB;
constexpr size_t WS_WGU = 56 * MiB;
constexpr size_t WS_WD = 120 * MiB;
constexpr size_t WS_HA = 152 * MiB;
constexpr size_t WS_BIG = 220 * MiB;
constexpr size_t SZ_ACT = 68 * MiB;
constexpr size_t WS_Q = WS_BIG, WS_K = WS_Q + SZ_ACT, WS_KFT = WS_K + SZ_ACT, WS_KBT = WS_KFT + SZ_ACT, WS_VT = WS_KBT + SZ_ACT, WS_GF = WS_VT + SZ_ACT, WS_GB = WS_GF + SZ_ACT;
constexpr size_t WS_PF = WS_GB + SZ_ACT;
constexpr size_t WS_PB = WS_PF + 100 * MiB;
constexpr size_t WS_UT = WS_PB + 100 * MiB + 72 * MiB;
constexpr size_t WS_ST = WS_PB + 100 * MiB;
constexpr size_t WS_END = WS_UT + 72 * MiB;
constexpr size_t WS_OF = WS_KFT, WS_OB = WS_KBT;
constexpr size_t WS_U = WS_BIG, WS_V = WS_U + SZ_ACT, WS_VT2 = WS_V + SZ_ACT;
constexpr size_t WS_XS = WS_BIG;
constexpr size_t WS_HID = WS_XS + 136 * MiB;
constexpr size_t WS_YE = WS_XS;
constexpr size_t PBLK = 65536;
constexpr size_t P_CTX_OFF = (size_t)32 * NX * 3 * PBLK;

constexpr int CW_BAR = 4096;

constexpr int RING_BYTES = 131072;
constexpr int MISC_OFF = RING_BYTES + 320;
constexpr int TR_OFF = RING_BYTES + 1024;
constexpr int LDS_BYTES = 155648;

#define VM_WAIT() asm volatile("s_waitcnt vmcnt(0)" ::: "memory")
#define LDS_WAIT() asm volatile("s_waitcnt lgkmcnt(0)" ::: "memory")
__device__ __forceinline__ unsigned cvt_pk_bf16(float lo, float hi) { unsigned r; asm volatile("v_cvt_pk_bf16_f32 %0, %1, %2" : "=v"(r) : "v"(lo), "v"(hi)); return r; }
__device__ __forceinline__ float bf_lo(unsigned u) { return __builtin_bit_cast(float, u << 16); }
__device__ __forceinline__ float bf_hi(unsigned u) { return __builtin_bit_cast(float, u & 0xffff0000u); }
__device__ __forceinline__ float bf1(bf16_t u) { return __builtin_bit_cast(float, (unsigned)u << 16); }
__device__ __forceinline__ bf16_t f2bf(float f) { return (bf16_t)(cvt_pk_bf16(f, 0.f) & 0xffffu); }
__device__ __forceinline__ float fexp2(float x) { return __builtin_amdgcn_exp2f(x); }
__device__ __forceinline__ float frcp(float x) { return __builtin_amdgcn_rcpf(x); }
__device__ __forceinline__ float sigmoidf_(float x) { return frcp(1.0f + fexp2(-1.4426950408889634f * x)); }
__device__ __forceinline__ float siluf_(float x) { return x * sigmoidf_(x); }
__device__ __forceinline__ float gelu_tanh(float x) { const float y = 1.5957691216057308f * (x + 0.044715f * x * x * x); return x * sigmoidf_(y); }
__device__ __forceinline__ float wave_sum(float v) {
#pragma unroll
    for (int o = 1; o < 64; o <<= 1) v += __shfl_xor(v, o);
    return v;
}

#define XB_TMO      128
#define XB_XCNT(j)  (256  + 64 * (j))
#define XB_XSUB(j)  (1280 + 64 * (j))
#define XB_XGEN(j)  (2304 + 64 * (j))
#define XB_TOP      3328
#define XB_TOPGEN   3392
#define XCD_BAR_WORDS 3456
#define XB_SPIN_CAP (1u << 18)
__device__ __forceinline__ unsigned xb_ld(unsigned* p)              { return __hip_atomic_load(p, __ATOMIC_RELAXED, __HIP_MEMORY_SCOPE_AGENT); }
__device__ __forceinline__ unsigned xb_add(unsigned* p, unsigned v) { return __hip_atomic_fetch_add(p, v, __ATOMIC_RELAXED, __HIP_MEMORY_SCOPE_AGENT); }
__device__ __forceinline__ unsigned xb_xcc_id() { return (unsigned)__builtin_amdgcn_s_getreg((3 << 11) | 20) & 0xFu; }
#define XB_SPIN(cond, bar) do { unsigned _sp = 0; while (cond) { __builtin_amdgcn_s_sleep(1); \
    if ((++_sp & 255u) == 0u) { if (xb_ld(&(bar)[XB_TMO])) break; if (_sp > XB_SPIN_CAP) { atomicAdd(&(bar)[XB_TMO], 1u); break; } } } } while (0)
struct XcdBarrier { unsigned* bar; unsigned x; volatile LAS unsigned* st; };
__device__ __forceinline__ XcdBarrier xcd_barrier_post(unsigned* bar, volatile LAS unsigned* st) {
    XcdBarrier b; b.bar = bar; b.x = xb_xcc_id(); b.st = st;
    if (threadIdx.x == 0) (void)xb_add(&bar[XB_XCNT(b.x)], 1u);
    return b;
}
__device__ __forceinline__ void xcd_barrier_complete(unsigned* bar, unsigned x, unsigned& nloc, unsigned& nx) {
    const unsigned G = gridDim.x * gridDim.y * gridDim.z;
    unsigned sum, cnt, mine, sp = 0u;
    for (;;) {
        sum = 0u; cnt = 0u; mine = 0u;
#pragma unroll
        for (unsigned j = 0; j < 16; ++j) { const unsigned c = xb_ld(&bar[XB_XCNT(j)]); sum += c; cnt += (c > 0u) ? 1u : 0u; mine = (j == x) ? c : mine; }
        if (sum == G) break;
        __builtin_amdgcn_s_sleep(1);
        if ((++sp & 255u) == 0u) { if (xb_ld(&bar[XB_TMO])) break; if (sp > XB_SPIN_CAP) { atomicAdd(&bar[XB_TMO], 1u); break; } }
    }
    nloc = mine > 0u ? mine : 1u; nx = cnt > 0u ? cnt : 1u;
}
__device__ __forceinline__ void xcd_barrier(const XcdBarrier& b) {
    asm volatile("s_waitcnt vmcnt(0)" ::: "memory");
    __syncthreads();
    if (threadIdx.x == 0) {
        unsigned* bar = b.bar;
        __builtin_amdgcn_s_waitcnt(0);
        unsigned nloc = b.st[0], nx = b.st[1];
        if (nloc == 0u) { xcd_barrier_complete(bar, b.x, nloc, nx); b.st[0] = nloc; b.st[1] = nx; }
        const unsigned old = xb_add(&bar[XB_XSUB(b.x)], 1u);
        const unsigned gen = old / nloc;
        if (old + 1u == (gen + 1u) * nloc) {
            __builtin_amdgcn_fence(__ATOMIC_RELEASE, "agent");
            asm volatile("s_waitcnt vmcnt(0)" ::: "memory");
            const unsigned og = xb_add(&bar[XB_TOP], 1u);
            const unsigned tg = og / nx;
            if (og + 1u == (tg + 1u) * nx) xb_add(&bar[XB_TOPGEN], 1u);
            else XB_SPIN(xb_ld(&bar[XB_TOPGEN]) == tg, bar);
            __builtin_amdgcn_fence(__ATOMIC_ACQUIRE, "agent");
            xb_add(&bar[XB_XGEN(b.x)], 1u);
            asm volatile("s_waitcnt vmcnt(0)" ::: "memory");
        } else {
            XB_SPIN(xb_ld(&bar[XB_XGEN(b.x)]) == gen, bar);
            __builtin_amdgcn_fence(__ATOMIC_ACQUIRE, "agent");
            asm volatile("s_waitcnt vmcnt(0)" ::: "memory");
        }
    }
    __syncthreads();
}

struct Params {
    const float *x, *c, *ctx, *c_ctx, *ada_w, *ada_b, *norm_mix_g, *norm_ffn_g, *a_w_in, *a_ln_g, *a_ln_b, *a_w_s, *a_b_s, *a_w_out,
                *r_w_in, *r_decay_f, *r_decay_b, *r_w_out, *moe_w_router, *moe_w_gate, *moe_w_up, *moe_w_down, *final_norm_g;
    float* out;
    unsigned char* ws;
    int ph_lo, ph_hi;
};

typedef const __attribute__((address_space(4))) Params* KParams;
__device__ __forceinline__ void load_params(Params& P, KParams k) {
    P.x = k->x; P.c = k->c; P.ctx = k->ctx; P.c_ctx = k->c_ctx; P.ada_w = k->ada_w; P.ada_b = k->ada_b; P.norm_mix_g = k->norm_mix_g; P.norm_ffn_g = k->norm_ffn_g;
    P.a_w_in = k->a_w_in; P.a_ln_g = k->a_ln_g; P.a_ln_b = k->a_ln_b; P.a_w_s = k->a_w_s; P.a_b_s = k->a_b_s; P.a_w_out = k->a_w_out; P.r_w_in = k->r_w_in;
    P.r_decay_f = k->r_decay_f; P.r_decay_b = k->r_decay_b; P.r_w_out = k->r_w_out; P.moe_w_router = k->moe_w_router; P.moe_w_gate = k->moe_w_gate; P.moe_w_up = k->moe_w_up;
    P.moe_w_down = k->moe_w_down; P.final_norm_g = k->final_norm_g; P.out = k->out; P.ws = k->ws; P.ph_lo = k->ph_lo; P.ph_hi = k->ph_hi;
}

namespace gm {
constexpr int BM = 256, BK = 64, HALF = 128, HTB = HALF * BK * 2, NXCD = 8, WGM = 4;
__device__ __forceinline__ int lds_byte(int r, int c) { const int st = (r >> 4) * 2 + (c >> 5), rr = r & 15, cc = c & 31, ob = rr * 64 + cc * 2; return st * 1024 + (ob ^ (((ob >> 9) & 1) << 5)); }
__device__ __forceinline__ int perm32(int rho) { const int n = rho >> 4, i = rho & 15; return 8 * (i >> 2) + 4 * n + (i & 3); }
__device__ __forceinline__ void stage_rc(int b, int& R, int& C) { const int st = b / 1024, sb = b % 1024, swz = sb ^ (((sb >> 9) & 1) << 5); R = (st >> 1) * 16 + swz / 64; C = (st & 1) * 32 + (swz % 64) / 2; }

struct Unit { const char* A0; const char* B0; const char* A1; const char* B1; int nt; int i0, i1, i2, i3; };
typedef f32x4 Acc[2][2][4][2];

__device__ __forceinline__ void tile_order(int L, int nM, int nN, int& pm, int& pn) {
    const int nwg = nM * nN; int wgid = L;
    { const int q = nwg / NXCD, r = nwg % NXCD, xcd = wgid % NXCD, off = wgid / NXCD; wgid = (xcd < r ? xcd * (q + 1) : r * (q + 1) + (xcd - r) * q) + off; }
    const int nig = WGM * nN, gid = wgid / nig, fm = gid * WGM, gsz = (nM - fm) < WGM ? (nM - fm) : WGM;
    pm = fm + ((wgid % nig) % gsz); pn = (wgid % nig) / gsz;
}

template <class Epi, class Sched>
__device__ __forceinline__ void gemm_units(LAS unsigned char* lds, const int tid, const Sched& S, const Epi& E) {
    const int wid = __builtin_amdgcn_readfirstlane(tid >> 6), lane = tid & 63, wr = wid >> 2, wc = wid & 3, fr = lane & 15, fq = lane >> 4;
    unsigned sR[2], sRb[2], sC[2];
#pragma unroll
    for (int i = 0; i < 2; ++i) { int R, C; stage_rc(tid * 16 + i * 8192, R, C); sR[i] = (unsigned)R; sC[i] = (unsigned)C * 2u; sRb[i] = Epi::PERM ? (unsigned)((R & ~31) + perm32(R & 31)) : (unsigned)R; }
    const unsigned ldsw = (unsigned)wid * 1024u;
    const int aoff = lds_byte(wr * 64 + fr, fq * 8), boff = lds_byte(wc * 32 + fr, fq * 8);
#define G_SA(b, h) (((b) * 2 + (h)) * HTB)
#define G_SB(b, h) ((4 + (b) * 2 + (h)) * HTB)
#define G_STAGE(bufoff, gbase, ld) do { _Pragma("unroll") for (int _i = 0; _i < 2; ++_i) \
        __builtin_amdgcn_global_load_lds((const unsigned*)((const char*)(gbase) + (sR[_i] * (ld) + sC[_i])), (LAS unsigned*)(lds + (bufoff) + ldsw + _i * 8192), 16, 0, 0); } while (0)
#define G_STAGE_B(bufoff, gbase, ld) do { _Pragma("unroll") for (int _i = 0; _i < 2; ++_i) \
        __builtin_amdgcn_global_load_lds((const unsigned*)((const char*)(gbase) + (sRb[_i] * (ld) + sC[_i])), (LAS unsigned*)(lds + (bufoff) + ldsw + _i * 8192), 16, 0, 0); } while (0)
#define G_STAGE_A(bufoff, abase, ld, h, nx) do { if constexpr (Sched::GATHER) { _Pragma("unroll") for (int _i = 0; _i < 2; ++_i) \
        __builtin_amdgcn_global_load_lds((const unsigned*)((const char*)(abase) + (((nx) ? gn[h][_i] : gc[h][_i]) + sC[_i])), (LAS unsigned*)(lds + (bufoff) + ldsw + _i * 8192), 16, 0, 0); } \
        else { G_STAGE(bufoff, (const char*)(abase) + (size_t)((h) * HALF) * (ld), ld); } } while (0)
#define G_LDA(dst, b, h) do { _Pragma("unroll") for (int m = 0; m < 4; ++m) _Pragma("unroll") for (int k = 0; k < 2; ++k) dst[m][k] = *(const LAS bf16x8*)(lds + G_SA(b, h) + aoff + m * 2048 + k * 1024); } while (0)
#define G_LDB(dst, b, h) do { _Pragma("unroll") for (int n = 0; n < 2; ++n) _Pragma("unroll") for (int k = 0; k < 2; ++k) dst[n][k] = *(const LAS bf16x8*)(lds + G_SB(b, h) + boff + n * 2048 + k * 1024); } while (0)
#define G_MMA(ai, bj, At, Bt) do { __builtin_amdgcn_s_setprio(1); _Pragma("unroll") for (int m = 0; m < 4; ++m) _Pragma("unroll") for (int n = 0; n < 2; ++n) _Pragma("unroll") for (int k = 0; k < 2; ++k) \
        acc[ai][bj][m][n] = __builtin_amdgcn_mfma_f32_16x16x32_bf16(Bt[n][k], At[m][k], acc[ai][bj][m][n], 0, 0, 0); __builtin_amdgcn_s_setprio(0); } while (0)
#define G_WAIT_V(n) asm volatile("s_waitcnt vmcnt(" #n ")" ::: "memory")
#define G_WAIT_L(n) asm volatile("s_waitcnt lgkmcnt(" #n ")" ::: "memory")
#define G_BAR __builtin_amdgcn_s_barrier()
#define G_SCHED __builtin_amdgcn_sched_barrier(0)
    Unit cur, nxt; int ui = 0;
    if (!S.next(0, cur)) return;
    unsigned gc[2][2], gn[2][2];
    if constexpr (Sched::GATHER) {
#pragma unroll
        for (int h = 0; h < 2; ++h)
#pragma unroll
            for (int i = 0; i < 2; ++i) { gc[h][i] = (unsigned)S.gidx[(size_t)cur.i0 * 256 + 128 * h + sR[i]] * S.lda0; gn[h][i] = gc[h][i]; }
    }
    Acc acc;
#pragma unroll
    for (int a = 0; a < 2; ++a)
#pragma unroll
        for (int b = 0; b < 2; ++b)
#pragma unroll
            for (int m = 0; m < 4; ++m)
#pragma unroll
                for (int n = 0; n < 2; ++n) acc[a][b][m][n] = (f32x4){0.f, 0.f, 0.f, 0.f};
    bf16x8 At[4][2], B0[2][2], B1[2][2];
    {
        const char *a0, *b0; unsigned la, lb; S.tile(cur, 0, a0, b0, la, lb);
        const size_t hb = (size_t)HALF * lb;
        G_STAGE_B(G_SB(0, 0), b0, lb); G_STAGE_B(G_SB(0, 1), b0 + hb, lb); G_STAGE_A(G_SA(0, 0), a0, la, 0, false); G_STAGE_A(G_SA(0, 1), a0, la, 1, false);
        if (wr == 1) G_BAR;
        G_WAIT_V(2); G_BAR;
        G_STAGE_B(G_SB(1, 0), b0 + 128, lb); G_STAGE_A(G_SA(1, 0), a0 + 128, la, 0, false); G_STAGE_B(G_SB(1, 1), b0 + hb + 128, lb);
        G_WAIT_V(6); G_BAR;
    }
    for (;;) {
        const bool has_next = S.next(ui + 1, nxt);
        if constexpr (Sched::GATHER) { if (has_next) {
#pragma unroll
            for (int h = 0; h < 2; ++h)
#pragma unroll
                for (int i = 0; i < 2; ++i) gn[h][i] = (unsigned)S.gidx[(size_t)nxt.i0 * 256 + 128 * h + sR[i]] * S.lda0; } }
        const int NT = cur.nt;
#pragma unroll 1
        for (int t = 0; t < NT; t += 2) {
            const bool last = (t == NT - 2);
            const char *a1, *b1_; unsigned la1, lb1; S.tile(cur, t + 1, a1, b1_, la1, lb1);
            const char *a2, *b2; unsigned la2, lb2;
            if (!last) S.tile(cur, t + 2, a2, b2, la2, lb2);
            else if (has_next) S.tile(nxt, 0, a2, b2, la2, lb2);
            else S.tile(cur, 0, a2, b2, la2, lb2);
            const char* a3 = a2 + 128; const char* b3 = b2 + 128;
            const size_t hb2 = (size_t)HALF * lb2;
            if constexpr (Sched::HOOK) { if (t == S.hook_t) E.hook(acc, cur); }
            G_LDB(B0, 0, 0); G_LDB(B1, 0, 1); G_SCHED; G_LDA(At, 0, 0); G_STAGE_A(G_SA(1, 1), a1, la1, 1, false);
            G_WAIT_V(8); G_WAIT_L(0); G_BAR; G_MMA(0, 0, At, B0); G_MMA(0, 1, At, B1); G_BAR; G_SCHED;
            G_LDA(At, 0, 1); G_STAGE_B(G_SB(0, 0), b2, lb2); G_STAGE_B(G_SB(0, 1), b2 + hb2, lb2); G_STAGE_A(G_SA(0, 0), a2, la2, 0, last);
            G_WAIT_V(8); G_WAIT_L(0); G_BAR; G_MMA(1, 0, At, B0); G_MMA(1, 1, At, B1); G_BAR; G_SCHED;
            G_LDB(B0, 1, 0); G_LDB(B1, 1, 1); G_SCHED; G_LDA(At, 1, 0); G_STAGE_A(G_SA(0, 1), a2, la2, 1, last);
            G_WAIT_V(8); G_WAIT_L(0); G_BAR; G_MMA(0, 0, At, B0); G_MMA(0, 1, At, B1); G_BAR; G_SCHED;
            G_LDA(At, 1, 1); G_STAGE_B(G_SB(1, 0), b3, lb2); G_STAGE_B(G_SB(1, 1), b3 + hb2, lb2); G_STAGE_A(G_SA(1, 0), a3, la2, 0, last);
            G_WAIT_V(8); G_WAIT_L(0); G_BAR; G_MMA(1, 0, At, B0); G_MMA(1, 1, At, B1); G_BAR; G_SCHED;
        }
        if (wr == 0) G_BAR;
        E(acc, cur);
        if (!has_next) break;
#pragma unroll
        for (int a = 0; a < 2; ++a)
#pragma unroll
            for (int b = 0; b < 2; ++b)
#pragma unroll
                for (int m = 0; m < 4; ++m)
#pragma unroll
                    for (int n = 0; n < 2; ++n) acc[a][b][m][n] = (f32x4){0.f, 0.f, 0.f, 0.f};
        cur = nxt; ++ui;
        if (wr == 1) G_BAR;
        if constexpr (Sched::GATHER) {
#pragma unroll
            for (int h = 0; h < 2; ++h)
#pragma unroll
                for (int i = 0; i < 2; ++i) gc[h][i] = gn[h][i]; }
    }
    G_WAIT_V(0);
    G_BAR;
#undef G_SA
#undef G_SB
#undef G_STAGE
#undef G_STAGE_A
#undef G_STAGE_B
#undef G_LDA
#undef G_LDB
#undef G_MMA
#undef G_WAIT_V
#undef G_WAIT_L
#undef G_BAR
#undef G_SCHED
}

template <bool GA> struct SchedGT {
    static constexpr bool HOOK = false, GATHER = GA; const int* gidx;
    const char* A; const char* Bt; unsigned lda0, ldb0; int nt;
    int nM, nN;
    int nM2, nN2, pm2, pn2;
    int tpg_eff, tpg_full;
    size_t bgs;
    int G, c;
    __device__ __forceinline__ void tile(const Unit& u, int kt, const char*& a, const char*& b, unsigned& lda, unsigned& ldb) const { a = u.A0 + (size_t)kt * 128; b = u.B0 + (size_t)kt * 128; lda = lda0; ldb = ldb0; }
    __device__ __forceinline__ bool next(int i, Unit& u) const {
        int L = i * G + c; const int n1 = nM * nN;
        int pm, pn;
        if (L < n1) tile_order(L, nM, nN, pm, pn);
        else { L -= n1; if (L >= nM2 * nN2) return false; tile_order(L, nM2, nN2, pm, pn); pm += pm2; pn += pn2; }
        const int e = pm / tpg_eff, pg = e * tpg_full + (pm - e * tpg_eff);
        u.A0 = GA ? A : A + (size_t)pg * 256 * lda0; u.B0 = Bt + (size_t)e * bgs + (size_t)pn * 256 * ldb0; u.nt = nt; u.i0 = pg; u.i1 = pn; u.i2 = e; u.i3 = 0; u.A1 = u.A0; u.B1 = u.B0;
        return true;
    }
};
typedef SchedGT<false> SchedG;
struct SchedState {
    static constexpr bool HOOK = false, GATHER = false;
    const char* VT; const char* KFT; const char* KBT; unsigned lda0, ldb0; int G, c; int u0, nu, coff;
    __device__ __forceinline__ void tile(const Unit& u, int kt, const char*& a, const char*& b, unsigned& lda, unsigned& ldb) const { a = u.A0 + (size_t)kt * 128; b = u.B0 + (size_t)kt * 128; lda = lda0; ldb = ldb0; }
    __device__ __forceinline__ bool next(int i, Unit& u) const {
        const int Lw = i * G + c - coff; if (Lw < 0 || Lw >= nu) return false;
        const int L = u0 + Lw;
        int bh, X, dir;
        { const int xcd = L & 7, jj = L >> 3, q = (jj >> 1) * 8 + xcd; dir = jj & 1;
          if (q < 256) { X = q & 7; bh = q >> 3; } else { X = 8; bh = q - 256; } }
        const size_t off = ((size_t)bh * 256 * TOK + (size_t)X * SCH) * 2;
        u.A0 = VT + off; u.B0 = (dir ? KBT : KFT) + off; u.nt = (X < 8) ? 8 : 4; u.i0 = (bh * 9 + X) * 2 + dir; u.i1 = u.i2 = u.i3 = 0; u.A1 = u.A0; u.B1 = u.B0;
        return true;
    }
};
struct SchedAtt {
    static constexpr bool HOOK = false, GATHER = false;
    const char* Q; const char* K; unsigned lda0, ldb0; int nlat, nctx, G, c;
    __device__ __forceinline__ void tile(const Unit& u, int kt, const char*& a, const char*& b, unsigned& lda, unsigned& ldb) const { a = u.A0 + (size_t)kt * 128; b = u.B0 + (size_t)kt * 128; lda = lda0; ldb = ldb0; }
    __device__ __forceinline__ bool next(int i, Unit& u) const {
        const int L = i * G + c; if (L >= nlat + nctx) return false;
        int bh, X, pm, pn; size_t row0;
        if (L < nlat) { const int xcd = L & 7, jj = L >> 3, q = (jj >> 2) * 8 + xcd; pn = jj & 1; pm = (jj >> 1) & 1; X = q & 7; bh = q >> 3;
            row0 = (size_t)(bh >> 2) * SEQ + (size_t)X * SCH; }
        else { bh = L - nlat; X = 8; pm = pn = 0; row0 = (size_t)ROWS_L + (size_t)(bh >> 2) * CTXL; }
        const size_t hoff = (size_t)(bh & 3) * DH * 2;
        u.A0 = Q + (row0 + pm * 256) * 2048 + hoff; u.B0 = K + (row0 + pn * 256) * 2048 + hoff; u.nt = 4; u.i0 = bh; u.i1 = X; u.i2 = pm; u.i3 = pn; u.A1 = u.A0; u.B1 = u.B0;
        return true;
    }
};
struct SchedOut {
    static constexpr bool HOOK = true, GATHER = false;
    const char* Q; const char* ST; const char* PF; const char* PB; const char* VT;
    unsigned lda0, ldb0, lda1, ldb1; int hook_t; int nlat, nctx, G, c;
    __device__ __forceinline__ void tile(const Unit& u, int kt, const char*& a, const char*& b, unsigned& lda, unsigned& ldb) const {
        const int s = kt >> 2, r = kt & 3;
        if (s == 0) { a = u.A0 + (size_t)r * 128; b = u.B0 + (size_t)r * 128; lda = lda0; ldb = ldb0; }
        else { a = u.A1 + (size_t)(s - 1) * (PBLK * 2) + (size_t)r * 128; b = u.B1 + (size_t)(s - 1) * 512 + (size_t)r * 128; lda = lda1; ldb = ldb1; }
    }
    __device__ __forceinline__ bool next(int i, Unit& u) const {
        const int dir = i & 1, Pp = (i >> 1) * G + c, nlp = nlat >> 1; if (Pp >= ((nlat + nctx) >> 1)) return false;
        int bh, X, pm; size_t row0;
        if (Pp < nlp) { const int xcd = Pp & 7, jj = Pp >> 3, q = (jj >> 1) * 8 + xcd; pm = jj & 1; X = q & 7; bh = q >> 3;
            row0 = (size_t)(bh >> 2) * SEQ + (size_t)X * SCH; }
        else { bh = Pp - nlp; X = 8; pm = 0; row0 = (size_t)ROWS_L + (size_t)(bh >> 2) * CTXL; }
        u.A0 = Q + (row0 + pm * 256) * 2048 + (size_t)(bh & 3) * DH * 2;
        u.B0 = ST + (size_t)((bh * 9 + X) * 2 + dir) * PBLK * 2;
        const int nblk = X == 8 ? 1 : (dir ? 2 - pm : pm + 1), kb0 = dir ? pm : 0;
        const size_t pbase = X < 8 ? (size_t)((bh * NX + X) * 3 + pm + kb0) * PBLK : P_CTX_OFF + (size_t)bh * PBLK;
        u.A1 = (dir ? PB : PF) + pbase * 2;
        u.B1 = VT + ((size_t)bh * 256 * TOK + (X < 8 ? (size_t)X * SCH : (size_t)SEQ) + (size_t)kb0 * 256) * 2;
        u.nt = 4 + 4 * nblk; u.i0 = bh; u.i1 = X; u.i2 = pm; u.i3 = dir;
        return true;
    }
};

#define EPI_LANE() int _tz = threadIdx.x; asm volatile("" : "+v"(_tz)); const int wr = _tz >> 8, wc = (_tz >> 6) & 3, fr = _tz & 15, fq = (_tz >> 4) & 3
#define EPI_ROWS(ai, m) (128 * (ai) + 64 * wr + 16 * (m) + fr)
#define EPI_COLS(bj, n) (128 * (bj) + 32 * wc + 16 * (n) + 4 * fq)
#define EPI_COL8(bj) (128 * (bj) + 32 * wc + 8 * fq)
__device__ __forceinline__ void st_bf8(bf16_t* p, const f32x4 a, const f32x4 b) { u32x4 w; w.x = cvt_pk_bf16(a[0], a[1]); w.y = cvt_pk_bf16(a[2], a[3]); w.z = cvt_pk_bf16(b[0], b[1]); w.w = cvt_pk_bf16(b[2], b[3]); *(u32x4*)p = w; }
__device__ __forceinline__ void st_bf4(bf16_t* p, const f32x4 v) { u32x2 w; w.x = cvt_pk_bf16(v[0], v[1]); w.y = cvt_pk_bf16(v[2], v[3]); *(u32x2*)p = w; }

__device__ __forceinline__ float dpp_q1(float v) { return __builtin_bit_cast(float, __builtin_amdgcn_mov_dpp(__builtin_bit_cast(int, v), 0xB1, 0xF, 0xF, true)); }
__device__ __forceinline__ float dpp_q2(float v) { return __builtin_bit_cast(float, __builtin_amdgcn_mov_dpp(__builtin_bit_cast(int, v), 0x4E, 0xF, 0xF, true)); }
__device__ __forceinline__ f32x4 quad_transpose(const f32x4 x, const bool odd, const bool hi) {
    const float s0 = odd ? x[0] : x[1], s1 = odd ? x[2] : x[3]; const float r0 = dpp_q1(s0), r1 = dpp_q1(s1);
    const float a0 = odd ? r0 : x[0], a1 = odd ? x[1] : r0, a2 = odd ? r1 : x[2], a3 = odd ? x[3] : r1;
    const float t0 = hi ? a0 : a2, t1 = hi ? a1 : a3; const float q0 = dpp_q2(t0), q1 = dpp_q2(t1);
    return (f32x4){hi ? q0 : a0, hi ? q1 : a1, hi ? a2 : q0, hi ? a3 : q1};
}
struct EpiGelu {           static constexpr bool PERM = true;
    bf16_t* U; bf16_t* V; float* LNP;
    __device__ __forceinline__ void operator()(const Acc& acc, const Unit& u) const { EPI_LANE();
        const bool isv = u.i1 >= 4;
        bf16_t* dst = (isv ? V : U) + (size_t)u.i0 * 256 * D + (u.i1 & 3) * 256;
#pragma unroll
        for (int ai = 0; ai < 2; ++ai)
#pragma unroll
            for (int m = 0; m < 4; ++m) { const int row = EPI_ROWS(ai, m); bf16_t* rp = dst + (size_t)row * D; float sm = 0.f, sq = 0.f;
#pragma unroll
                for (int bj = 0; bj < 2; ++bj) { f32x4 g[2];
#pragma unroll
                    for (int n = 0; n < 2; ++n) { const f32x4 a = acc[ai][bj][m][n]; g[n] = (f32x4){gelu_tanh(a[0]), gelu_tanh(a[1]), gelu_tanh(a[2]), gelu_tanh(a[3])};
                        sm += (g[n][0] + g[n][1]) + (g[n][2] + g[n][3]); sq += (g[n][0] * g[n][0] + g[n][1] * g[n][1]) + (g[n][2] * g[n][2] + g[n][3] * g[n][3]); }
                    st_bf8(rp + EPI_COL8(bj), g[0], g[1]); }
                if (isv) { sm += __shfl_xor(sm, 16); sq += __shfl_xor(sq, 16); sm += __shfl_xor(sm, 32); sq += __shfl_xor(sq, 32);
                    if (fq == 0) *(f32x2*)(LNP + (((size_t)u.i0 * 256 + row) * 16 + (u.i1 - 4) * 4 + wc) * 2) = (f32x2){sm, sq}; } }
    }
};
struct EpiRes {            static constexpr bool PERM = false;
    const float* xs_l; const float* xs_c; float* xd_l; float* xd_c; const float* gate;
    __device__ __forceinline__ void operator()(const Acc& acc, const Unit& u) const { EPI_LANE();
        const int pm = u.i0, pn = u.i1; const bool lat = pm < 128;
        const float* src = lat ? xs_l + (size_t)pm * 256 * D : xs_c + (size_t)(pm - 128) * 256 * D;
        float* dst = lat ? xd_l + (size_t)pm * 256 * D : xd_c + (size_t)(pm - 128) * 256 * D;
        const float* gp = gate + (size_t)(lat ? (pm >> 4) : 8) * NMOD + pn * 256;
        f32x4 gv[2][2];
#pragma unroll
        for (int bj = 0; bj < 2; ++bj)
#pragma unroll
            for (int n = 0; n < 2; ++n) gv[bj][n] = *(const f32x4*)(gp + EPI_COLS(bj, n));
#pragma unroll
        for (int ai = 0; ai < 2; ++ai)
#pragma unroll
            for (int m = 0; m < 4; ++m) { const size_t ro = (size_t)EPI_ROWS(ai, m) * D + pn * 256;
#pragma unroll
                for (int bj = 0; bj < 2; ++bj)
#pragma unroll
                    for (int n = 0; n < 2; ++n) { const int co = EPI_COLS(bj, n); const f32x4 xv = *(const f32x4*)(src + ro + co); *(f32x4*)(dst + ro + co) = xv + gv[bj][n] * acc[ai][bj][m][n]; } }
    }
};
struct EpiRetIn {          static constexpr bool PERM = true;
    bf16_t *Q, *K, *KFT, *KBT, *VT, *GF, *GB; const float* rope; const float* logg; LAS unsigned char* lds;
    __device__ __forceinline__ void operator()(const Acc& acc, const Unit& u) const { EPI_LANE();
        const int pm = u.i0, pn = u.i1, part = pn >> 2, h = pn & 3; const bool lat = pm < 128;
        const int b = lat ? (pm >> 4) : (pm - 128), n0 = lat ? (pm & 15) * 256 : 0;
        const size_t grow0 = (size_t)pm * 256;
        LAS bf16_t* T = (LAS bf16_t*)(lds + TR_OFF + (_tz >> 6) * 2304);
        const int cr = (_tz >> 2) & 15, tq = _tz & 3;
        const size_t tbase = ((size_t)(b * NH + h) * DH) * TOK + (lat ? 0 : SEQ);
        if (part == 0 || part == 1) {
            const float sc = part == 1 ? 0.0625f : 1.0f;
            bf16_t* dst = (part == 0 ? Q : K) + grow0 * D + h * DH;
            const float l2f = logg[h], l2b = logg[4 + h];
#pragma unroll
            for (int ai = 0; ai < 2; ++ai) {
                const int tr0 = n0 + 128 * ai + 64 * wr + 16 * tq;
                float dfr[16], dbr[16];
                if (part == 1) { const int nl0 = lat ? (tr0 & (SCH - 1)) : tr0, len = lat ? SCH : CTXL;
#pragma unroll
                    for (int i = 0; i < 16; ++i) { dfr[i] = fexp2(l2f * (float)(len - 1 - nl0 - i)); dbr[i] = fexp2(l2b * (float)(nl0 + i)); } }
#pragma unroll
                for (int nn = 0; nn < 2; ++nn) {
                    const int i0 = 32 * wc + 8 * fq + 4 * nn;
                    f32x4 o1[4], o2[4];
#pragma unroll
                    for (int m = 0; m < 4; ++m) {
                        const int row = EPI_ROWS(ai, m), n = n0 + row;
                        const int pos = (wc < 2) ? (n >> 6) : (n & 63);
                        const f32x4 t1 = acc[ai][0][m][nn] * sc, t2 = acc[ai][1][m][nn] * sc;
                        if (lat) {
#pragma unroll
                            for (int j = 0; j < 4; ++j) { const f32x2 cs = *(const f32x2*)(rope + ((size_t)pos * 64 + ((i0 + j) & 63)) * 2);
                                o1[m][j] = t1[j] * cs.x - t2[j] * cs.y; o2[m][j] = t1[j] * cs.y + t2[j] * cs.x; }
                        } else { o1[m] = t1; o2[m] = t2; }
                        bf16_t* rp = dst + (size_t)row * D;
                        st_bf4(rp + i0, o1[m]); st_bf4(rp + 128 + i0, o2[m]);
                    }
                    if (part == 1) {
#pragma unroll
                        for (int half = 0; half < 2; ++half) {
                            asm volatile("" ::: "memory");
#pragma unroll
                            for (int m = 0; m < 4; ++m)
#pragma unroll
                                for (int j = 0; j < 4; ++j) T[(4 * fq + j) * 72 + 16 * m + fr] = f2bf(half ? o2[m][j] : o1[m][j]);
                            asm volatile("" ::: "memory");
                            const u32x4 r0 = *(const LAS u32x4*)(T + cr * 72 + tq * 16), r1 = *(const LAS u32x4*)(T + cr * 72 + tq * 16 + 8);
                            asm volatile("" ::: "memory");
                            const int col = half * 128 + 32 * wc + 8 * (cr >> 2) + 4 * nn + (cr & 3);
                            const size_t to = tbase + (size_t)col * TOK + (size_t)tr0;
                            float vv[16];
#pragma unroll
                            for (int k = 0; k < 4; ++k) { vv[2 * k] = bf_lo(r0[k]); vv[2 * k + 1] = bf_hi(r0[k]); vv[8 + 2 * k] = bf_lo(r1[k]); vv[8 + 2 * k + 1] = bf_hi(r1[k]); }
                            st_bf8(KFT + to, (f32x4){vv[0] * dfr[0], vv[1] * dfr[1], vv[2] * dfr[2], vv[3] * dfr[3]}, (f32x4){vv[4] * dfr[4], vv[5] * dfr[5], vv[6] * dfr[6], vv[7] * dfr[7]});
                            st_bf8(KFT + to + 8, (f32x4){vv[8] * dfr[8], vv[9] * dfr[9], vv[10] * dfr[10], vv[11] * dfr[11]}, (f32x4){vv[12] * dfr[12], vv[13] * dfr[13], vv[14] * dfr[14], vv[15] * dfr[15]});
                            st_bf8(KBT + to, (f32x4){vv[0] * dbr[0], vv[1] * dbr[1], vv[2] * dbr[2], vv[3] * dbr[3]}, (f32x4){vv[4] * dbr[4], vv[5] * dbr[5], vv[6] * dbr[6], vv[7] * dbr[7]});
                            st_bf8(KBT + to + 8, (f32x4){vv[8] * dbr[8], vv[9] * dbr[9], vv[10] * dbr[10], vv[11] * dbr[11]}, (f32x4){vv[12] * dbr[12], vv[13] * dbr[13], vv[14] * dbr[14], vv[15] * dbr[15]});
                        }
                    }
                }
            }
        } else if (part == 2) {
#pragma unroll
            for (int ai = 0; ai < 2; ++ai) { const size_t tr0 = (size_t)(n0 + 128 * ai + 64 * wr + 16 * tq);
#pragma unroll
                for (int bj = 0; bj < 2; ++bj)
#pragma unroll
                    for (int nn = 0; nn < 2; ++nn) {
                        asm volatile("" ::: "memory");
#pragma unroll
                        for (int m = 0; m < 4; ++m)
#pragma unroll
                            for (int j = 0; j < 4; ++j) T[(4 * fq + j) * 72 + 16 * m + fr] = f2bf(acc[ai][bj][m][nn][j]);
                        asm volatile("" ::: "memory");
                        const u32x4 r0 = *(const LAS u32x4*)(T + cr * 72 + tq * 16), r1 = *(const LAS u32x4*)(T + cr * 72 + tq * 16 + 8);
                        asm volatile("" ::: "memory");
                        const int col = 128 * bj + 32 * wc + 8 * (cr >> 2) + 4 * nn + (cr & 3);
                        bf16_t* vp = VT + tbase + (size_t)col * TOK + tr0;
                        *(u32x4*)vp = r0; *(u32x4*)(vp + 8) = r1; } }
        } else {
            bf16_t* dst = (part == 3 ? GF : GB) + grow0 * D + h * DH;
#pragma unroll
            for (int ai = 0; ai < 2; ++ai)
#pragma unroll
                for (int m = 0; m < 4; ++m) { bf16_t* rp = dst + (size_t)EPI_ROWS(ai, m) * D;
#pragma unroll
                    for (int bj = 0; bj < 2; ++bj) { const f32x4 a = acc[ai][bj][m][0], b2 = acc[ai][bj][m][1];
                        st_bf8(rp + EPI_COL8(bj), (f32x4){siluf_(a[0]), siluf_(a[1]), siluf_(a[2]), siluf_(a[3])}, (f32x4){siluf_(b2[0]), siluf_(b2[1]), siluf_(b2[2]), siluf_(b2[3])}); } }
        }
    }
};
struct EpiBlk {            static constexpr bool PERM = true;
    bf16_t* C;
    __device__ __forceinline__ void operator()(const Acc& acc, const Unit& u) const { EPI_LANE();
        bf16_t* dst = C + (size_t)u.i0 * PBLK;
#pragma unroll
        for (int ai = 0; ai < 2; ++ai)
#pragma unroll
            for (int m = 0; m < 4; ++m) { bf16_t* rp = dst + (size_t)EPI_ROWS(ai, m) * 256;
#pragma unroll
                for (int bj = 0; bj < 2; ++bj) st_bf8(rp + EPI_COL8(bj), acc[ai][bj][m][0], acc[ai][bj][m][1]); }
    }
};
struct EpiAtt {            static constexpr bool PERM = true;
    bf16_t* PF; bf16_t* PB; const float* logg;
    template <int DIR> __device__ __forceinline__ void one(const Acc& acc, bf16_t* dst, const float sg, const bool diag, const int dlt, int wr, int wc, int fr, int fq) const {
        float cf[2][2][4];
#pragma unroll
        for (int bj = 0; bj < 2; ++bj)
#pragma unroll
            for (int n = 0; n < 2; ++n)
#pragma unroll
                for (int j = 0; j < 4; ++j) cf[bj][n][j] = fexp2(-sg * (float)(EPI_COL8(bj) + 4 * n + j));
#pragma unroll
        for (int ai = 0; ai < 2; ++ai)
#pragma unroll
            for (int m = 0; m < 4; ++m) { const int row = EPI_ROWS(ai, m); const float rf = fexp2(sg * (float)(row + dlt));
                bf16_t* rp = dst + (size_t)row * 256;
#pragma unroll
                for (int bj = 0; bj < 2; ++bj) { f32x4 v[2];
#pragma unroll
                    for (int n = 0; n < 2; ++n) { const int c0 = EPI_COL8(bj) + 4 * n;
#pragma unroll
                        for (int j = 0; j < 4; ++j) { float w = acc[ai][bj][m][n][j] * (rf * cf[bj][n][j]);
                            if (diag) { const int sd = DIR ? (c0 + j) - row : row - (c0 + j) + 1; w *= (float)min(max(sd, 0), 1); }
                            v[n][j] = w; } }
                    st_bf8(rp + EPI_COL8(bj), v[0], v[1]); }
                __builtin_amdgcn_sched_barrier(0); }
    }
    __device__ __forceinline__ void operator()(const Acc& acc, const Unit& u) const { EPI_LANE();
        const int bh = u.i0, X = u.i1, pm = u.i2, pn = u.i3, h = bh & 3;
        const size_t base = (X < 8 ? (size_t)((bh * NX + X) * 3) * PBLK : P_CTX_OFF + (size_t)bh * PBLK) + (size_t)(pm + pn) * PBLK;
        const bool diag = pm == pn; const int dlt = (pm - pn) * 256;
        if (pn <= pm) one<0>(acc, PF + base, logg[h], diag, dlt, wr, wc, fr, fq);
        if (pn >= pm) one<1>(acc, PB + base, -logg[4 + h], diag, dlt, wr, wc, fr, fq);
    }
};
struct EpiOut {            static constexpr bool PERM = true;
    bf16_t* YR; const bf16_t* GF; const bf16_t* GB; const float* logg; LAS unsigned char* lds;
    __device__ __forceinline__ void hook(Acc& acc, const Unit& u) const { EPI_LANE();
        const int h = u.i0 & 3, pm = u.i2, dir = u.i3; const float l2 = logg[dir * 4 + h];
#pragma unroll
        for (int ai = 0; ai < 2; ++ai)
#pragma unroll
            for (int m = 0; m < 4; ++m) { const int nl = pm * 256 + EPI_ROWS(ai, m); const float d = fexp2(l2 * (float)(dir == 0 ? nl + 1 : SCH - nl));
#pragma unroll
                for (int bj = 0; bj < 2; ++bj)
#pragma unroll
                    for (int n = 0; n < 2; ++n) acc[ai][bj][m][n] *= d; }
    }
    __device__ __forceinline__ void operator()(const Acc& acc, const Unit& u) const { EPI_LANE();
        const int bh = u.i0, X = u.i1, pm = u.i2, dir = u.i3;
        const size_t row0 = (X < 8 ? (size_t)(bh >> 2) * SEQ + (size_t)X * SCH : (size_t)ROWS_L + (size_t)(bh >> 2) * CTXL) + pm * 256;
        const size_t base = row0 * D + (bh & 3) * DH;
        LAS float* Pst = (LAS float*)(lds + TR_OFF);
#pragma unroll
        for (int ai = 0; ai < 2; ++ai)
#pragma unroll
            for (int m = 0; m < 4; ++m) { float sm = 0.f, sq = 0.f;
#pragma unroll
                for (int bj = 0; bj < 2; ++bj)
#pragma unroll
                    for (int n = 0; n < 2; ++n) { const f32x4 a = acc[ai][bj][m][n]; sm += (a[0] + a[1]) + (a[2] + a[3]); sq += (a[0] * a[0] + a[1] * a[1]) + (a[2] * a[2] + a[3] * a[3]); }
                sm += __shfl_xor(sm, 16); sq += __shfl_xor(sq, 16); sm += __shfl_xor(sm, 32); sq += __shfl_xor(sq, 32);
                if (fq == 0) *(LAS f32x2*)(Pst + (EPI_ROWS(ai, m) * 4 + wc) * 2) = (f32x2){sm, sq}; }
        asm volatile("s_waitcnt lgkmcnt(0)" ::: "memory"); __builtin_amdgcn_s_barrier(); asm volatile("" ::: "memory");
        const bf16_t* G = dir ? GB : GF;
#pragma unroll
        for (int ai = 0; ai < 2; ++ai) {
            u32x4 gq[4][2], yq[4][2];
#pragma unroll
            for (int m = 0; m < 4; ++m)
#pragma unroll
                for (int bj = 0; bj < 2; ++bj) { const size_t o = base + (size_t)EPI_ROWS(ai, m) * D + EPI_COL8(bj); gq[m][bj] = *(const u32x4*)(G + o); yq[m][bj] = dir ? *(const u32x4*)(YR + o) : (u32x4){0u, 0u, 0u, 0u}; }
#pragma unroll
            for (int m = 0; m < 4; ++m) { const int row = EPI_ROWS(ai, m);
                const f32x4 p0 = *(const LAS f32x4*)(Pst + row * 8), p1 = *(const LAS f32x4*)(Pst + row * 8 + 4);
                const float mean = ((p0[0] + p0[2]) + (p1[0] + p1[2])) * (1.0f / DH), var = ((p0[1] + p0[3]) + (p1[1] + p1[3])) * (1.0f / DH) - mean * mean, rstd = 1.0f / sqrtf(var + EPS);
#pragma unroll
                for (int bj = 0; bj < 2; ++bj) { const u32x4 g4 = gq[m][bj], y4 = yq[m][bj]; f32x4 o0, o1;
#pragma unroll
                    for (int k = 0; k < 2; ++k) { o0[2 * k] = bf_lo(g4[k]) * (acc[ai][bj][m][0][2 * k] - mean) * rstd + bf_lo(y4[k]); o0[2 * k + 1] = bf_hi(g4[k]) * (acc[ai][bj][m][0][2 * k + 1] - mean) * rstd + bf_hi(y4[k]);
                                                 o1[2 * k] = bf_lo(g4[2 + k]) * (acc[ai][bj][m][1][2 * k] - mean) * rstd + bf_lo(y4[2 + k]); o1[2 * k + 1] = bf_hi(g4[2 + k]) * (acc[ai][bj][m][1][2 * k + 1] - mean) * rstd + bf_hi(y4[2 + k]); }
                    st_bf8(YR + base + (size_t)row * D + EPI_COL8(bj), o0, o1); } }
        }
    }
};
struct EpiSwiglu {         static constexpr bool PERM = true;
    bf16_t* HID;
    __device__ __forceinline__ void operator()(const Acc& acc, const Unit& u) const { EPI_LANE();
        bf16_t* dst = HID + (size_t)u.i0 * 256 * D + u.i1 * 128;
#pragma unroll
        for (int ai = 0; ai < 2; ++ai)
#pragma unroll
            for (int m = 0; m < 4; ++m) { bf16_t* rp = dst + (size_t)EPI_ROWS(ai, m) * D;
                { f32x4 hv[2];
#pragma unroll
                  for (int n = 0; n < 2; ++n) { const f32x4 g = acc[ai][0][m][n], w = acc[ai][1][m][n]; hv[n] = (f32x4){siluf_(g[0]) * w[0], siluf_(g[1]) * w[1], siluf_(g[2]) * w[2], siluf_(g[3]) * w[3]}; }
                  st_bf8(rp + 32 * wc + 8 * fq, hv[0], hv[1]); } }
    }
};
struct EpiDown {           static constexpr bool PERM = true;
    bf16_t* YE; const float* gate;
    __device__ __forceinline__ void operator()(const Acc& acc, const Unit& u) const { EPI_LANE();
        bf16_t* dst = YE + (size_t)u.i0 * 256 * D + u.i1 * 256;
#pragma unroll
        for (int ai = 0; ai < 2; ++ai)
#pragma unroll
            for (int m = 0; m < 4; ++m) { const int row = EPI_ROWS(ai, m); bf16_t* rp = dst + (size_t)row * D;
#pragma unroll
                for (int bj = 0; bj < 2; ++bj) st_bf8(rp + EPI_COL8(bj), acc[ai][bj][m][0], acc[ai][bj][m][1]); }
    }
};
}

struct Frame {
    LAS unsigned char* lds; int tid, lane, wave, vcu, G, bx;
    unsigned char* ws;
};
__device__ __forceinline__ void frame_init(Frame& F, LAS unsigned char* lds) {
    int tz = threadIdx.x, bz = blockIdx.x, gz = gridDim.x;
    asm volatile("" : "+v"(tz)); asm volatile("" : "+s"(bz)); asm volatile("" : "+s"(gz));
    F.lds = lds; F.tid = tz; F.lane = tz & 63; F.wave = __builtin_amdgcn_readfirstlane(tz >> 6); F.G = gz; F.bx = bz;
    F.vcu = (gz % 8 == 0) ? (bz % 8) * (gz / 8) + bz / 8 : bz; F.ws = nullptr;
}
#define WSP(T, off) ((T*)(F.ws + (off)))

__device__ __forceinline__ void ph_mod(const Frame& F, const Params& p) {
    LAS float* sc = (LAS float*)F.lds;
    LAS float* part = (LAS float*)(F.lds + 36864);
    for (int idx = F.tid; idx < 9 * D; idx += 512) { const int m = idx >> 10, k = idx & 1023; const float v = m < 8 ? p.c[m * D + k] : p.c_ctx[k]; sc[idx] = siluf_(v); }
    __syncthreads();
    float* MOD = WSP(float, WS_MOD);
    for (int t = F.vcu; t < 4 * 48; t += F.G) {
        const int L = t / 48, cb = t % 48;
        float a0[9], a1[9];
#pragma unroll
        for (int m = 0; m < 9; ++m) { a0[m] = 0.f; a1[m] = 0.f; }
        const float* wp = p.ada_w + ((size_t)L * D + F.wave * 128) * NMOD + cb * 128 + F.lane * 2;
        for (int k = 0; k < 128; ++k) {
            const f32x2 w = *(const f32x2*)(wp + (size_t)k * NMOD);
#pragma unroll
            for (int m = 0; m < 9; ++m) { const float s = sc[m * D + F.wave * 128 + k]; a0[m] += s * w.x; a1[m] += s * w.y; }
        }
#pragma unroll
        for (int m = 0; m < 9; ++m) { part[(F.wave * 9 + m) * 128 + F.lane * 2] = a0[m]; part[(F.wave * 9 + m) * 128 + F.lane * 2 + 1] = a1[m]; }
        __syncthreads();
        for (int idx = F.tid; idx < 9 * 128; idx += 512) { const int m = idx >> 7, col = idx & 127; float s = 0.f;
#pragma unroll
            for (int w = 0; w < 8; ++w) s += part[(w * 9 + m) * 128 + col];
            MOD[((size_t)L * 9 + m) * NMOD + cb * 128 + col] = s + p.ada_b[(size_t)L * NMOD + cb * 128 + col]; }
        __syncthreads();
    }
}
__device__ __forceinline__ void ph_tables(const Frame& F, const Params& p) {
    if (F.vcu == F.G - 1) {
        float* rope = WSP(float, WS_ROPE);
        for (int idx = F.tid; idx < 64 * 64; idx += 512) { const int pos = idx >> 6, j = idx & 63;
            const float inv = fexp2(-(float)j * (13.287712379549449f / 64.0f));
            const float ang = (float)pos * inv; float rev = ang * 0.15915494309189535f; rev -= floorf(rev);
            rope[idx * 2] = __builtin_amdgcn_cosf(rev); rope[idx * 2 + 1] = __builtin_amdgcn_sinf(rev); }
        float* logg = WSP(float, WS_LOGG);
        if (F.tid < 16) { const int j = F.tid >> 3, dir = (F.tid >> 2) & 1, h = F.tid & 3; const float x = (dir ? p.r_decay_b : p.r_decay_f)[j * 4 + h];
            logg[F.tid] = -log1pf(expf(-x)) * 1.4426950408889634f; }
    }
}
__device__ __forceinline__ void tr_item(const float* W, int K, int N, bf16_t* WT, int k0, int n0, int out_row0, LAS float* scr, int lane) {
#pragma unroll 8
    for (int i = 0; i < 32; ++i) { const int kk = 2 * i + (lane >> 5); scr[kk * 33 + (lane & 31)] = W[(size_t)(k0 + kk) * N + n0 + (lane & 31)]; }
    LDS_WAIT(); asm volatile("" ::: "memory");
    const int c = lane & 7;
#pragma unroll
    for (int j = 0; j < 4; ++j) { const int n = (lane >> 3) + 8 * j; const LAS float* s = scr + (8 * c) * 33 + n;
        u32x4 o; o.x = cvt_pk_bf16(s[0 * 33], s[1 * 33]); o.y = cvt_pk_bf16(s[2 * 33], s[3 * 33]); o.z = cvt_pk_bf16(s[4 * 33], s[5 * 33]); o.w = cvt_pk_bf16(s[6 * 33], s[7 * 33]);
        *(u32x4*)(WT + (size_t)(out_row0 + n) * K + k0 + 8 * c) = o; }
    LDS_WAIT(); asm volatile("" ::: "memory");
}
__device__ __forceinline__ void tr_item16(const float* W, int K, int N, bf16_t* WT, int k0, int n0, int out_row0, LAS float* scr, int lane) {
    const int c4 = (lane & 15) * 4, r4 = lane >> 4;
#pragma unroll
    for (int i = 0; i < 8; ++i) { const int kk = 4 * i + r4; *(LAS f32x4*)(scr + kk * 68 + c4) = __builtin_nontemporal_load((const f32x4*)(W + (size_t)(k0 + kk) * N + n0 + c4)); }
    LDS_WAIT(); asm volatile("" ::: "memory");
    const int kq = lane & 3;
#pragma unroll
    for (int pss = 0; pss < 4; ++pss) { const int n = (lane >> 2) + 16 * pss; const LAS float* sp = scr + (8 * kq) * 68 + n;
        u32x4 o; o.x = cvt_pk_bf16(sp[0 * 68], sp[1 * 68]); o.y = cvt_pk_bf16(sp[2 * 68], sp[3 * 68]); o.z = cvt_pk_bf16(sp[4 * 68], sp[5 * 68]); o.w = cvt_pk_bf16(sp[6 * 68], sp[7 * 68]);
        *(u32x4*)(WT + (size_t)(out_row0 + n) * K + k0 + 8 * kq) = o; }
    LDS_WAIT(); asm volatile("" ::: "memory");
}
__device__ __forceinline__ void ph_wconv_small(const Frame& F, const Params& p) {
    LAS float* scr = (LAS float*)(F.lds + F.wave * 8704);
    const int gw = F.vcu * 8 + F.wave, NGW = F.G * 8;
    constexpr int I_AIN = 16 * 64, I_AOUT = 16 * 32, I_RIN = 16 * 160, I_ROUT = 16 * 32;
    constexpr int NIT = 2 * (I_AIN + I_AOUT + I_RIN + I_ROUT);
    for (int it = gw; it < NIT; it += NGW) {
        int r = it; const int j = r & 1; r >>= 1;
        if (r < I_AIN) { const int nb = r % 64, kb = r / 64; tr_item(p.a_w_in + (size_t)j * D * 2048, D, 2048, WSP(bf16_t, WS_WAIN) + (size_t)j * 2048 * D, kb * 64, nb * 32, nb * 32, scr, F.lane); continue; } r -= I_AIN;
        if (r < I_AOUT) { const int nb = r % 32, kb = r / 32; tr_item(p.a_w_out + (size_t)j * D * D, D, D, WSP(bf16_t, WS_WAOUT) + (size_t)j * D * D, kb * 64, nb * 32, nb * 32, scr, F.lane); continue; } r -= I_AOUT;
        if (r < I_RIN) { const int nb = r % 160, kb = r / 160; tr_item(p.r_w_in + (size_t)j * D * 5120, D, 5120, WSP(bf16_t, WS_WRIN) + (size_t)j * 5120 * D, kb * 64, nb * 32, nb * 32, scr, F.lane); continue; } r -= I_RIN;
        { const int nb = r % 32, kb = r / 32; tr_item(p.r_w_out + (size_t)j * D * D, D, D, WSP(bf16_t, WS_WROUT) + (size_t)j * D * D, kb * 64, nb * 32, nb * 32, scr, F.lane); }
    }
    bf16_t* wsb = WSP(bf16_t, WS_WSB);
    for (int i = (F.vcu * 512 + F.tid) * 4; i < 2 * 8 * 128 * 128; i += F.G * 512 * 4) { const f32x4 v = *(const f32x4*)(p.a_w_s + i); u32x2 w; w.x = cvt_pk_bf16(v[0], v[1]); w.y = cvt_pk_bf16(v[2], v[3]); *(u32x2*)(wsb + i) = w; }
}
constexpr int CW_WCQ = 16384;
__device__ __forceinline__ void ph_wconv_moe(const Frame& F, const Params& p, int L) {
    LAS float* scr = (LAS float*)(F.lds + F.wave * 8704);
    const int gw = F.vcu * 8 + F.wave, NGW = F.G * 8;
    constexpr int IPM = 32 * 16;
    for (int it = gw; it < NEXP * 3 * IPM; it += NGW) {
        const int e = it / (3 * IPM), r = it % (3 * IPM), which = r / IPM, q = r % IPM, nb = q % 16, kb = q / 16, n0 = nb * 64;
        const size_t wo = ((size_t)L * NEXP + e) * D * D;
        if (which < 2) tr_item16((which == 0 ? p.moe_w_gate : p.moe_w_up) + wo, D, D, WSP(bf16_t, WS_WGU) + (size_t)e * 2048 * D, kb * 32, n0, (n0 >> 7) * 256 + (n0 & 127) + which * 128, scr, F.lane);
        else tr_item16(p.moe_w_down + wo, D, D, WSP(bf16_t, WS_WD) + (size_t)e * D * D, kb * 32, n0, n0, scr, F.lane);
    }
}
__device__ __forceinline__ float* resid_row(const Frame& F, const Params& p, int r) { return r < ROWS_L ? p.out + (size_t)r * D : WSP(float, WS_XC) + (size_t)(r - ROWS_L) * D; }
__device__ __forceinline__ int mod_row(int r) { return r < ROWS_L ? (r >> 12) : 8; }

__device__ __forceinline__ void moe_combine(const Frame& F, int r, int Lp, f32x4 (&v)[4], int myslot) {
    const bf16_t* YE = WSP(bf16_t, WS_YE); const float* MOD = WSP(float, WS_MOD); const float* GATE = WSP(float, WS_GATE);
    f32x4 s[4];
#pragma unroll
    for (int j = 0; j < 4; ++j) s[j] = (f32x4){0.f, 0.f, 0.f, 0.f};
    unsigned long long m = __ballot(myslot >= 0) & 0xffffull;
    while (m) {
        const int e0 = __builtin_ctzll(m); m &= m - 1; const bool two = m != 0ull; const int e1 = two ? __builtin_ctzll(m) : e0; if (two) m &= m - 1;
        const int s0 = __shfl(myslot, e0), s1 = __shfl(myslot, e1);
        const bf16_t* y0 = YE + ((size_t)e0 * EROWS + s0) * D + 4 * F.lane; const bf16_t* y1 = YE + ((size_t)e1 * EROWS + s1) * D + 4 * F.lane;
        const float g0 = GATE[(size_t)e0 * EROWS + s0], g1 = two ? GATE[(size_t)e1 * EROWS + s1] : 0.f;
        u32x2 w0[4], w1[4];
#pragma unroll
        for (int j = 0; j < 4; ++j) { w0[j] = *(const u32x2*)(y0 + 256 * j); w1[j] = *(const u32x2*)(y1 + 256 * j); }
#pragma unroll
        for (int j = 0; j < 4; ++j) { s[j] += (f32x4){bf_lo(w0[j].x), bf_hi(w0[j].x), bf_lo(w0[j].y), bf_hi(w0[j].y)} * g0;
            s[j] += (f32x4){bf_lo(w1[j].x), bf_hi(w1[j].x), bf_lo(w1[j].y), bf_hi(w1[j].y)} * g1; }
    }
    const float* g2 = MOD + ((size_t)Lp * 9 + mod_row(r)) * NMOD + 5 * D + 4 * F.lane;
#pragma unroll
    for (int j = 0; j < 4; ++j) v[j] += *(const f32x4*)(g2 + 256 * j) * s[j];
}
__device__ __forceinline__ void ph_t1(const Frame& F, const Params& p, int L, int nrows) {
    const int gw = F.vcu * 8 + F.wave, NGW = F.G * 8;
    const float* MOD = WSP(float, WS_MOD); bf16_t* HA = WSP(bf16_t, WS_HA); const int* slotmap = WSP(int, WS_SLOT);
    f32x4 vn[4]; int sn = -1;
#define T1_LOAD(rr) do { const float* xr_ = (L == 0 ? ((rr) < ROWS_L ? p.x + (size_t)(rr) * D : p.ctx + (size_t)((rr) - ROWS_L) * D) : (const float*)resid_row(F, p, (rr))) + 4 * F.lane; \
        _Pragma("unroll") for (int j = 0; j < 4; ++j) vn[j] = *(const f32x4*)(xr_ + 256 * j); \
        sn = -1; if (L != 0 && F.lane < 16) sn = slotmap[(size_t)(rr) * 16 + F.lane]; } while (0)
    if (gw < nrows) T1_LOAD(gw);
    for (int r = gw; r < nrows; r += NGW) {
        f32x4 v[4]; const int myslot = sn;
#pragma unroll
        for (int j = 0; j < 4; ++j) v[j] = vn[j];
        if (r + NGW < nrows) T1_LOAD(r + NGW);
        if (L != 0) { moe_combine(F, r, L - 1, v, myslot); float* xr = resid_row(F, p, r) + 4 * F.lane;
#pragma unroll
            for (int j = 0; j < 4; ++j) *(f32x4*)(xr + 256 * j) = v[j]; }
        float ss = 0.f;
#pragma unroll
        for (int j = 0; j < 4; ++j) ss += (v[j][0] * v[j][0] + v[j][1] * v[j][1]) + (v[j][2] * v[j][2] + v[j][3] * v[j][3]);
        const float rs = 1.0f / sqrtf(wave_sum(ss) * (1.0f / D) + EPS);
        const float* mp = MOD + ((size_t)L * 9 + mod_row(r)) * NMOD + 4 * F.lane; const float* gp = p.norm_mix_g + (size_t)L * D + 4 * F.lane;
        bf16_t* hr = HA + (size_t)r * D + 4 * F.lane;
#pragma unroll
        for (int j = 0; j < 4; ++j) { const f32x4 g = *(const f32x4*)(gp + 256 * j), sh = *(const f32x4*)(mp + 256 * j), sc = *(const f32x4*)(mp + D + 256 * j);
            gm::st_bf4(hr + 256 * j, (v[j] * rs * g) * (sc + 1.0f) + sh); }
    }
#undef T1_LOAD
}
__device__ __forceinline__ void ph_spatial(const Frame& F, const Params& p, int j, int nchunks) {
    const bf16_t* V = WSP(bf16_t, WS_V); const bf16_t* U = WSP(bf16_t, WS_U); bf16_t* P = WSP(bf16_t, WS_HA); const float* LNP = WSP(float, WS_VT2);
    LAS bf16_t* As = (LAS bf16_t*)F.lds; LAS bf16_t* Bs = (LAS bf16_t*)(F.lds + 128 * 272);
    const int g = F.vcu & 7;
    const int w4 = F.wave >> 1, w2 = F.wave & 1, fr = F.lane & 15, fq = F.lane >> 4;
    const int tok = F.tid >> 2, cs = F.tid & 3;
    { const bf16_t* a = WSP(bf16_t, WS_WSB) + (((size_t)j * 8 + g) * 128 + tok) * 128 + cs * 32;
#pragma unroll
      for (int q4 = 0; q4 < 4; ++q4) *(LAS u32x4*)(As + tok * 136 + cs * 32 + q4 * 8) = *(const u32x4*)(a + q4 * 8); }
    float lgv[32], lbv[32];
    { const float* lgp = p.a_ln_g + (size_t)j * D + g * 128 + cs * 32; const float* lbp = p.a_ln_b + (size_t)j * D + g * 128 + cs * 32;
#pragma unroll
      for (int q = 0; q < 8; ++q) { const f32x4 a = *(const f32x4*)(lgp + 4 * q), b = *(const f32x4*)(lbp + 4 * q);
#pragma unroll
          for (int k = 0; k < 4; ++k) { lgv[4 * q + k] = a[k]; lbv[4 * q + k] = b[k]; } } }
    float bsv[2];
#pragma unroll
    for (int mi = 0; mi < 2; ++mi) bsv[mi] = p.a_b_s[((size_t)j * 8 + g) * 128 + 32 * w4 + 16 * mi + fr];
    u32x4 vq[4]; f32x4 lp[2];
#define G2_LOAD(tt) do { const int ch_ = (tt) >> 3; const bf16_t* vr_ = V + ((size_t)ch_ * 128 + tok) * D + g * 128 + cs * 32; \
        _Pragma("unroll") for (int q4 = 0; q4 < 4; ++q4) vq[q4] = *(const u32x4*)(vr_ + q4 * 8); \
        const f32x4* pp_ = (const f32x4*)(LNP + ((size_t)ch_ * 128 + tok) * 32) + 2 * cs; lp[0] = pp_[0]; lp[1] = pp_[1]; } while (0)
    const int ntask = nchunks * 8;
    if (F.vcu < ntask) G2_LOAD(F.vcu);
    for (int t = F.vcu; t < ntask; t += F.G) {
        const int ch = t >> 3;
        float sm = (lp[0][0] + lp[0][2]) + (lp[1][0] + lp[1][2]), sq = (lp[0][1] + lp[0][3]) + (lp[1][1] + lp[1][3]);
        sm += __shfl_xor(sm, 1); sq += __shfl_xor(sq, 1); sm += __shfl_xor(sm, 2); sq += __shfl_xor(sq, 2);
        const float mean = sm * (1.0f / D), rstd = 1.0f / sqrtf(sq * (1.0f / D) - mean * mean + EPS);
#pragma unroll
        for (int q4 = 0; q4 < 4; ++q4)
#pragma unroll
            for (int k = 0; k < 4; ++k) { const int cl = q4 * 8 + k * 2;
                Bs[(cs * 32 + cl) * 136 + tok] = f2bf((bf_lo(vq[q4][k]) - mean) * rstd * lgv[cl] + lbv[cl]); Bs[(cs * 32 + cl + 1) * 136 + tok] = f2bf((bf_hi(vq[q4][k]) - mean) * rstd * lgv[cl + 1] + lbv[cl + 1]); }
        u32x2 uu[2][4];
#pragma unroll
        for (int mi = 0; mi < 2; ++mi) { const size_t ro = ((size_t)ch * 128 + 32 * w4 + 16 * mi + fr) * D + g * 128;
#pragma unroll
            for (int ni = 0; ni < 4; ++ni) uu[mi][ni] = *(const u32x2*)(U + ro + 64 * w2 + 16 * ni + 4 * fq); }
        __syncthreads();
        if (t + F.G < ntask) G2_LOAD(t + F.G);
        f32x4 acc[2][4];
#pragma unroll
        for (int mi = 0; mi < 2; ++mi)
#pragma unroll
            for (int ni = 0; ni < 4; ++ni) acc[mi][ni] = (f32x4){0.f, 0.f, 0.f, 0.f};
#pragma unroll
        for (int ks = 0; ks < 4; ++ks) { bf16x8 af[2], bfr[4];
#pragma unroll
            for (int mi = 0; mi < 2; ++mi) af[mi] = *(const LAS bf16x8*)(As + (32 * w4 + 16 * mi + fr) * 136 + ks * 32 + fq * 8);
#pragma unroll
            for (int ni = 0; ni < 4; ++ni) bfr[ni] = *(const LAS bf16x8*)(Bs + (64 * w2 + 16 * ni + fr) * 136 + ks * 32 + fq * 8);
#pragma unroll
            for (int mi = 0; mi < 2; ++mi)
#pragma unroll
                for (int ni = 0; ni < 4; ++ni) acc[mi][ni] = __builtin_amdgcn_mfma_f32_16x16x32_bf16(bfr[ni], af[mi], acc[mi][ni], 0, 0, 0); }
#pragma unroll
        for (int mi = 0; mi < 2; ++mi) { const size_t ro = ((size_t)ch * 128 + 32 * w4 + 16 * mi + fr) * D + g * 128;
#pragma unroll
            for (int ni = 0; ni < 4; ++ni) { const int d0 = 64 * w2 + 16 * ni + 4 * fq; const u32x2 u2 = uu[mi][ni]; const f32x4 sv = acc[mi][ni] + bsv[mi];
                gm::st_bf4(P + ro + d0, (f32x4){bf_lo(u2.x) * sv[0], bf_hi(u2.x) * sv[1], bf_lo(u2.y) * sv[2], bf_hi(u2.y) * sv[3]}); } }
        __syncthreads();
    }
#undef G2_LOAD
}
__device__ __forceinline__ void ph_prefix(const Frame& F, const Params& p, int j) {
    const bf16_t* UT = WSP(bf16_t, WS_UT); bf16_t* ST = WSP(bf16_t, WS_ST); const float* logg = WSP(float, WS_LOGG) + j * 8;
#define UT_LD(o_) ({ const u32x2 w_ = *(const u32x2*)(UT + (o_)); (f32x4){bf_lo(w_.x), bf_hi(w_.x), bf_lo(w_.y), bf_hi(w_.y)}; })
    const int nq = 32 * 2 * (int)(PBLK / 4);
    for (int q = F.vcu * 512 + F.tid; q < nq; q += F.G * 512) {
        const int e4 = q & (int)(PBLK / 4 - 1), dir = (q >> 14) & 1, bh = q >> 15;
        const float dec = fexp2(logg[dir * 4 + (bh & 3)] * (float)SCH);
        f32x4 S = UT_LD((size_t)((bh * 9 + 8) * 2 + dir) * PBLK + e4 * 4);
        gm::st_bf4(ST + (size_t)((bh * 9 + 8) * 2 + dir) * PBLK + e4 * 4, (f32x4){0.f, 0.f, 0.f, 0.f});
        for (int s = 0; s < NX; ++s) { const int X = dir ? (NX - 1 - s) : s; const size_t o = (size_t)((bh * 9 + X) * 2 + dir) * PBLK + e4 * 4;
            gm::st_bf4(ST + o, S); S = S * dec + UT_LD(o); }
    }
#undef UT_LD
}
__device__ __forceinline__ float half_sum(float v) {
#pragma unroll
    for (int o = 1; o < 32; o <<= 1) v += __shfl_xor(v, o);
    return v;
}
__device__ __forceinline__ void ph_headnorm(const Frame& F, int nrows) {
    const int gw = F.vcu * 8 + F.wave, NGW = F.G * 8;
    const bf16_t* OF = WSP(bf16_t, WS_OF); const bf16_t* OB = WSP(bf16_t, WS_OB); const bf16_t* GF = WSP(bf16_t, WS_GF); const bf16_t* GB = WSP(bf16_t, WS_GB); bf16_t* YR = WSP(bf16_t, WS_HA);
    u32x4 wn[2][2], gqn[2][2];
#define HN_LOAD(rr) do { const size_t o_ = (size_t)(rr) * D + 8 * F.lane; _Pragma("unroll") for (int k = 0; k < 2; ++k) _Pragma("unroll") for (int dir = 0; dir < 2; ++dir) { \
        wn[k][dir] = *(const u32x4*)((dir ? OB : OF) + o_ + 512 * k); gqn[k][dir] = *(const u32x4*)((dir ? GB : GF) + o_ + 512 * k); } } while (0)
    if (gw < nrows) HN_LOAD(gw);
    for (int r = gw; r < nrows; r += NGW) { const size_t o = (size_t)r * D + 8 * F.lane;
        u32x4 wc_[2][2], gc_[2][2];
#pragma unroll
        for (int k = 0; k < 2; ++k)
#pragma unroll
            for (int dir = 0; dir < 2; ++dir) { wc_[k][dir] = wn[k][dir]; gc_[k][dir] = gqn[k][dir]; }
        if (r + NGW < nrows) HN_LOAD(r + NGW);
#pragma unroll
        for (int k = 0; k < 2; ++k) { float y[8];
#pragma unroll
            for (int q = 0; q < 8; ++q) y[q] = 0.f;
#pragma unroll
            for (int dir = 0; dir < 2; ++dir) { const u32x4 w = wc_[k][dir], gq = gc_[k][dir];
                float v[8], g[8];
#pragma unroll
                for (int q = 0; q < 4; ++q) { v[2 * q] = bf_lo(w[q]); v[2 * q + 1] = bf_hi(w[q]); g[2 * q] = bf_lo(gq[q]); g[2 * q + 1] = bf_hi(gq[q]); }
                const float mean = half_sum(((v[0] + v[1]) + (v[2] + v[3])) + ((v[4] + v[5]) + (v[6] + v[7]))) * (1.0f / DH); float sq = 0.f;
#pragma unroll
                for (int q = 0; q < 8; ++q) { v[q] -= mean; sq += v[q] * v[q]; }
                const float rstd = 1.0f / sqrtf(half_sum(sq) * (1.0f / DH) + EPS);
#pragma unroll
                for (int q = 0; q < 8; ++q) y[q] += g[q] * v[q] * rstd; }
            u32x4 ow; ow.x = cvt_pk_bf16(y[0], y[1]); ow.y = cvt_pk_bf16(y[2], y[3]); ow.z = cvt_pk_bf16(y[4], y[5]); ow.w = cvt_pk_bf16(y[6], y[7]);
            *(u32x4*)(YR + o + 512 * k) = ow; } }
#undef HN_LOAD
}
__device__ __forceinline__ void rt_fill(const Frame& F, const Params& p, int L) {
    LAS float* wt = (LAS float*)F.lds;
    for (int i = F.tid * 4; i < D * NEXP; i += 512 * 4) { const f32x4 w = *(const f32x4*)(p.moe_w_router + (size_t)L * D * NEXP + i); const int k = i >> 4, e0 = i & 15;
        wt[(e0 + 0) * D + k] = w[0]; wt[(e0 + 1) * D + k] = w[1]; wt[(e0 + 2) * D + k] = w[2]; wt[(e0 + 3) * D + k] = w[3]; }
    __syncthreads();
}
template <int NR>
__device__ __forceinline__ void rt_rows(const Frame& F, const Params& p, int L, int rbase, int rfirst, int rstride, int cnt) {
    LAS float* wt = (LAS float*)F.lds;
    const float* MOD = WSP(float, WS_MOD); bf16_t* HA = WSP(bf16_t, WS_HA); float* AFF = WSP(float, WS_AFF);
    const int gw = rbase + rfirst, NGW = rstride, nrows = rbase + rfirst + rstride * cnt;
    f32x4 vn[NR][4];
#define RT_LOAD(rz) do { _Pragma("unroll") for (int q = 0; q < NR; ++q) { const int rq_ = (rz) + q * NGW; const float* xq_ = resid_row(F, p, rq_ < nrows ? rq_ : (rz)) + 4 * F.lane; \
        _Pragma("unroll") for (int j = 0; j < 4; ++j) vn[q][j] = *(const f32x4*)(xq_ + 256 * j); } } while (0)
    if (gw < nrows) RT_LOAD(gw);
    for (int r0 = gw; r0 < nrows; r0 += NR * NGW) {
        int rr[NR]; bool ok[NR];
#pragma unroll
        for (int q = 0; q < NR; ++q) { const int rq = r0 + q * NGW; ok[q] = rq < nrows; rr[q] = ok[q] ? rq : r0; }
        f32x4 v[NR][4]; float lg[NR][16];
#pragma unroll
        for (int q = 0; q < NR; ++q)
#pragma unroll
            for (int j = 0; j < 4; ++j) v[q][j] = vn[q][j];
        { const int n0 = r0 + NR * NGW; if (n0 < nrows) RT_LOAD(n0); }
#pragma unroll
        for (int q = 0; q < NR; ++q) { float ss = 0.f;
#pragma unroll
            for (int j = 0; j < 4; ++j) ss += (v[q][j][0] * v[q][j][0] + v[q][j][1] * v[q][j][1]) + (v[q][j][2] * v[q][j][2] + v[q][j][3] * v[q][j][3]);
            const float rs = 1.0f / sqrtf(wave_sum(ss) * (1.0f / D) + EPS);
            const float* mp = MOD + ((size_t)L * 9 + mod_row(rr[q])) * NMOD + 3 * D + 4 * F.lane; const float* gp = p.norm_ffn_g + (size_t)L * D + 4 * F.lane;
            bf16_t* hr = HA + (size_t)rr[q] * D + 4 * F.lane;
#pragma unroll
            for (int j = 0; j < 4; ++j) { const f32x4 g = *(const f32x4*)(gp + 256 * j), sh = *(const f32x4*)(mp + 256 * j), sc = *(const f32x4*)(mp + D + 256 * j);
                v[q][j] = (v[q][j] * rs * g) * (sc + 1.0f) + sh; if (ok[q]) gm::st_bf4(hr + 256 * j, v[q][j]); } }
#pragma unroll
        for (int e = 0; e < 16; ++e) { f32x2 a[NR];
#pragma unroll
            for (int q = 0; q < NR; ++q) a[q] = (f32x2){0.f, 0.f};
#pragma unroll
            for (int j = 0; j < 4; ++j) { const f32x4 w = *(const LAS f32x4*)(wt + e * D + 4 * F.lane + 256 * j); const f32x2 wl = (f32x2){w[0], w[1]}, wh = (f32x2){w[2], w[3]};
#pragma unroll
                for (int q = 0; q < NR; ++q) { a[q] += (f32x2){v[q][j][0], v[q][j][1]} * wl; a[q] += (f32x2){v[q][j][2], v[q][j][3]} * wh; } }
#pragma unroll
            for (int q = 0; q < NR; ++q) lg[q][e] = a[q].x + a[q].y; }
        float lgt[NR];
#pragma unroll
        for (int q = 0; q < NR; ++q) {
#pragma unroll
            for (int i = 0; i < 8; ++i) { const bool up = (F.lane & 32) != 0; const float keep = up ? lg[q][i + 8] : lg[q][i], send = up ? lg[q][i] : lg[q][i + 8]; lg[q][i] = keep + __shfl_xor(send, 32); }
#pragma unroll
            for (int i = 0; i < 4; ++i) { const bool up = (F.lane & 16) != 0; const float keep = up ? lg[q][i + 4] : lg[q][i], send = up ? lg[q][i] : lg[q][i + 4]; lg[q][i] = keep + __shfl_xor(send, 16); }
#pragma unroll
            for (int i = 0; i < 2; ++i) { const bool up = (F.lane & 8) != 0; const float keep = up ? lg[q][i + 2] : lg[q][i], send = up ? lg[q][i] : lg[q][i + 2]; lg[q][i] = keep + __shfl_xor(send, 8); }
            { const bool up = (F.lane & 4) != 0; const float keep = up ? lg[q][1] : lg[q][0], send = up ? lg[q][0] : lg[q][1]; lg[q][0] = keep + __shfl_xor(send, 4); }
            float t = lg[q][0]; t += __shfl_xor(t, 2); t += __shfl_xor(t, 1); lgt[q] = t; }
#pragma unroll
        for (int q = 0; q < NR; ++q) { float mx = lgt[q];
#pragma unroll
            for (int o = 4; o < 64; o <<= 1) mx = fmaxf(mx, __shfl_xor(mx, o));
            const float pe = __expf(lgt[q] - mx); float den = pe;
#pragma unroll
            for (int o = 4; o < 64; o <<= 1) den += __shfl_xor(den, o);
            if ((F.lane & 3) == 0 && ok[q]) { const float a = pe / den; const int e = F.lane >> 2, r = rr[q];
                if (r < ROWS_L) AFF[((size_t)(r >> 12) * 16 + e) * SEQ + (r & (SEQ - 1))] = a;
                else { const int rc = r - ROWS_L; AFF[(size_t)128 * SEQ + ((size_t)(rc >> 8) * 16 + e) * CTXL + (rc & (CTXL - 1))] = a; } } }
    }
#undef RT_LOAD
}
__device__ __forceinline__ void ph_topk(const Frame& F, int ntasks) {
    LAS unsigned* keys = (LAS unsigned*)F.lds;
    LAS unsigned* hist = (LAS unsigned*)(F.lds + 16384);
    LAS unsigned* misc = (LAS unsigned*)(F.lds + 16384 + 1024);
    const float* AFF = WSP(float, WS_AFF); int* IDX = WSP(int, WS_IDX); float* GATE = WSP(float, WS_GATE); int* SLOT = WSP(int, WS_SLOT);
    for (int task = F.vcu; task < ntasks; task += F.G) {
        const bool lat = task < 128; const int be = lat ? task : task - 128, b = be >> 4, e = be & 15;
        const int n = lat ? SEQ : CTXL, cap = lat ? CAP_L : CAP_C;
        const float* src = AFF + (lat ? (size_t)be * SEQ : (size_t)128 * SEQ + (size_t)be * CTXL);
        for (int i = F.tid; i < n; i += 512) keys[i] = __builtin_bit_cast(unsigned, src[i]);
        if (F.tid == 0) { misc[0] = 0u; misc[1] = (unsigned)cap; }
        __syncthreads();
        unsigned mask = 0u;
        for (int pass = 0; pass < 4; ++pass) { const int shift = 24 - 8 * pass;
            if (F.tid < 256) hist[F.tid] = 0u;
            __syncthreads();
            const unsigned prefix = misc[0];
            for (int i = F.tid; i < n; i += 512) { const unsigned k = keys[i]; if ((k & mask) == prefix) __hip_atomic_fetch_add(&hist[(k >> shift) & 255u], 1u, __ATOMIC_RELAXED, __HIP_MEMORY_SCOPE_WORKGROUP); }
            __syncthreads();
            if (F.wave == 0) {
                const unsigned need = misc[1]; const u32x4 hc = *(const LAS u32x4*)(hist + 4 * F.lane); const unsigned sl = (hc[0] + hc[1]) + (hc[2] + hc[3]);
                unsigned suf = sl;
#pragma unroll
                for (int o = 1; o < 64; o <<= 1) { const unsigned t = __shfl_down(suf, o); if (F.lane + o < 64) suf += t; }
                const unsigned above = suf - sl;
                if (above < need && need <= above + sl) {
                    const unsigned c3 = above, c2 = c3 + hc[3], c1 = c2 + hc[2], c0 = c1 + hc[1];
                    const int d = (c3 + hc[3] >= need) ? 3 : (c2 + hc[2] >= need) ? 2 : (c1 + hc[1] >= need) ? 1 : 0;
                    const unsigned cum = d == 3 ? c3 : d == 2 ? c2 : d == 1 ? c1 : c0;
                    misc[0] = prefix | ((unsigned)(4 * F.lane + d) << shift); misc[1] = need - cum; } }
            mask |= 255u << shift;
            __syncthreads();
        }
        const unsigned T = misc[0], need_eq = misc[1];
        const int i0 = F.tid * 8; unsigned cg = 0u, ce = 0u; unsigned kk[8];
#pragma unroll
        for (int q = 0; q < 8; ++q) { const int i = i0 + q; kk[q] = (i < n) ? keys[i] : 0u; cg += (i < n && kk[q] > T) ? 1u : 0u; ce += (i < n && kk[q] == T) ? 1u : 0u; }
        unsigned pk = cg | (ce << 16), incl = pk;
#pragma unroll
        for (int o = 1; o < 64; o <<= 1) { const unsigned t = __shfl_up(incl, o); if (F.lane >= o) incl += t; }
        if (F.lane == 63) misc[8 + F.wave] = incl;
        __syncthreads();
        unsigned wbase = 0u;
#pragma unroll
        for (int w = 0; w < 8; ++w) wbase += (w < F.wave) ? misc[8 + w] : 0u;
        const unsigned excl = wbase + incl - pk; unsigned ng = excl & 0xffffu, ne = excl >> 16;
        const int slotbase = lat ? b * CAP_L : NB * CAP_L + b * CAP_C; const int rowbase = lat ? b * SEQ : ROWS_L + b * CTXL;
#pragma unroll
        for (int q = 0; q < 8; ++q) { const int i = i0 + q; if (i < n) {
                const bool gt = kk[q] > T, eq = kk[q] == T; const bool sel = gt || (eq && ne < need_eq);
                const int slot = slotbase + (int)(ng + (ne < need_eq ? ne : need_eq));
                if (sel) { IDX[e * EROWS + slot] = rowbase + i; GATE[e * EROWS + slot] = __builtin_bit_cast(float, kk[q]); }
                SLOT[(size_t)(rowbase + i) * 16 + e] = sel ? slot : -1;
                ng += gt ? 1u : 0u; ne += eq ? 1u : 0u; } }
        __syncthreads();
    }
}
__device__ __forceinline__ void ph_final(const Frame& F, const Params& p) {
    const int gw = F.vcu * 8 + F.wave, NGW = F.G * 8; const int* slotmap = WSP(int, WS_SLOT);
    f32x4 vn[4]; int sn = -1;
#define FN_LOAD(rr) do { const float* xr_ = p.out + (size_t)(rr) * D + 4 * F.lane; \
        _Pragma("unroll") for (int j = 0; j < 4; ++j) vn[j] = *(const f32x4*)(xr_ + 256 * j); \
        sn = -1; if (F.lane < 16) sn = slotmap[(size_t)(rr) * 16 + F.lane]; } while (0)
    if (gw < ROWS_L) FN_LOAD(gw);
    for (int r = gw; r < ROWS_L; r += NGW) { float* xr = p.out + (size_t)r * D + 4 * F.lane; f32x4 v[4]; const int myslot = sn;
#pragma unroll
        for (int j = 0; j < 4; ++j) v[j] = vn[j];
        if (r + NGW < ROWS_L) FN_LOAD(r + NGW);
        moe_combine(F, r, DEPTH - 1, v, myslot);
        float ss = 0.f;
#pragma unroll
        for (int j = 0; j < 4; ++j) ss += (v[j][0] * v[j][0] + v[j][1] * v[j][1]) + (v[j][2] * v[j][2] + v[j][3] * v[j][3]);
        const float rs = 1.0f / sqrtf(wave_sum(ss) * (1.0f / D) + EPS);
#pragma unroll
        for (int j = 0; j < 4; ++j) *(f32x4*)(xr + 256 * j) = v[j] * rs * *(const f32x4*)(p.final_norm_g + 4 * F.lane + 256 * j); }
#undef FN_LOAD
}

constexpr int CW_HND = 8192;
__device__ __forceinline__ void handoff_publish(const Frame& F, unsigned* ctr) {
    asm volatile("s_waitcnt vmcnt(0)" ::: "memory"); __syncthreads();
    if (F.tid == 0) { __builtin_amdgcn_fence(__ATOMIC_RELEASE, "agent"); asm volatile("s_waitcnt vmcnt(0)" ::: "memory"); (void)__hip_atomic_fetch_add(ctr, 1u, __ATOMIC_RELAXED, __HIP_MEMORY_SCOPE_AGENT); }
}
__device__ __forceinline__ void handoff_wait(const Frame& F, unsigned* ctr, unsigned need) {
    if (F.tid == 0) { unsigned sp = 0;
        while (__hip_atomic_load(ctr, __ATOMIC_RELAXED, __HIP_MEMORY_SCOPE_AGENT) < need) { __builtin_amdgcn_s_sleep(2); if (++sp > (1u << 20)) break; }
        __builtin_amdgcn_fence(__ATOMIC_ACQUIRE, "agent"); asm volatile("s_waitcnt vmcnt(0)" ::: "memory"); }
    __syncthreads();
}
constexpr int PH_PER_LAYER = 16, PH_FINAL = 1 + PH_PER_LAYER * DEPTH, PH_TOTAL = PH_FINAL + 1;

#ifdef PROBE_SITE
#ifndef PROBE_K
#define PROBE_K 8
#endif
#define PB(s) unsigned long long pt0_ = 0ull; if ((s) == PROBE_SITE) pt0_ = __builtin_amdgcn_s_memrealtime()
#define PE(s) if ((s) == PROBE_SITE) probe_acc += __builtin_amdgcn_s_memrealtime() - pt0_
#else
#define PB(s) do {} while (0)
#define PE(s) do {} while (0)
#endif
template <int ONLY> __global__ void __launch_bounds__(512, 2) mk_fwd(Params p) {
    extern __shared__ __attribute__((aligned(16))) unsigned char lds_raw[];
    Frame F0; frame_init(F0, (LAS unsigned char*)lds_raw);
    volatile LAS unsigned* MISC = (volatile LAS unsigned*)(F0.lds + MISC_OFF);
    if (F0.tid < 32) MISC[F0.tid] = 0u;
    __syncthreads();
#if MK_SINGLE
    XcdBarrier bar = xcd_barrier_post((unsigned*)(p.ws + WS_CTL) + CW_BAR, MISC + 8);
#define SEAM() do { XcdBarrier b_ = bar; asm volatile("" : "+s"(b_.bar)); xcd_barrier(b_); } while (0)
#else
#define SEAM() do {} while (0)
#endif
#ifdef PROBE_SITE
    unsigned long long probe_acc = 0ull;
#endif
    const int lo = p.ph_lo, hi = p.ph_hi;
#define IN(k) (lo <= (k) && (k) < hi)
#ifdef ONLY_SITE
#define SITE(s) ((s) == ONLY_SITE && (ONLY < 0 || (s) == ONLY))
#else
#define SITE(s) (ONLY < 0 || (s) == ONLY)
#endif
#define SITE_ENTER() KParams pp_ = (KParams)__builtin_amdgcn_kernarg_segment_ptr(); asm volatile("" : "+s"(pp_)); Params P; load_params(P, pp_); Frame F; frame_init(F, (LAS unsigned char*)lds_raw); F.ws = P.ws; const int c = F.bx; (void)c

    if (SITE(0) && IN(0)) { SITE_ENTER(); PB(0); ph_mod(F, P); ph_tables(F, P); ph_wconv_small(F, P); SEAM(); PE(0); }

#pragma unroll 1
    for (int L = 0; L < DEPTH; ++L) {
        const int base = 1 + PH_PER_LAYER * L, j = L >> 1; const bool last = (L == DEPTH - 1), kind1 = (L & 1) != 0;
        if (SITE(1) && IN(base + 0)) { SITE_ENTER(); PB(1); ph_wconv_moe(F, P, L); ph_t1(F, P, L, ROWS); SEAM(); PE(1); }
        if (!kind1) {
            if (SITE(2) && IN(base + 1)) {
                SITE_ENTER(); PB(2);
                gm::SchedG S{nullptr, (const char*)WSP(bf16_t, WS_HA), (const char*)(WSP(bf16_t, WS_WAIN) + (size_t)j * 2048 * D), 2048u, 2048u, 16, ROWS / 256, 8, 0, 0, 0, 0, ROWS / 256, ROWS / 256, 0, F.G, c};
                gm::EpiGelu E{WSP(bf16_t, WS_U), WSP(bf16_t, WS_V), WSP(float, WS_VT2)};
                gm::gemm_units(F.lds, F.tid, S, E); SEAM(); PE(2); }
            if (SITE(4) && IN(base + 3)) { SITE_ENTER(); PB(4); ph_spatial(F, P, j, ROWS / 128); SEAM(); PE(4); }
            if (SITE(5) && IN(base + 4)) {
                SITE_ENTER(); PB(5);
                gm::SchedG S{nullptr, (const char*)WSP(bf16_t, WS_HA), (const char*)(WSP(bf16_t, WS_WAOUT) + (size_t)j * D * D), 2048u, 2048u, 16, 128, 4, 0, 0, 0, 0, ROWS / 256, ROWS / 256, 0, F.G, c};
                gm::EpiRes E{(L == 0) ? P.x : P.out, (L == 0) ? P.ctx : WSP(float, WS_XC), P.out, WSP(float, WS_XC), WSP(float, WS_MOD) + (size_t)L * 9 * NMOD + 2 * D};
                gm::gemm_units(F.lds, F.tid, S, E); SEAM(); PE(5); }
        } else {
            if (SITE(6) && IN(base + 1)) {
                SITE_ENTER(); PB(6);
                gm::SchedG S{nullptr, (const char*)WSP(bf16_t, WS_HA), (const char*)(WSP(bf16_t, WS_WRIN) + (size_t)j * 5120 * D), 2048u, 2048u, 16, 128, 20, 0, 0, 0, 0, ROWS / 256, ROWS / 256, 0, F.G, c};
                gm::EpiRetIn E{WSP(bf16_t, WS_Q), WSP(bf16_t, WS_K), WSP(bf16_t, WS_KFT), WSP(bf16_t, WS_KBT), WSP(bf16_t, WS_VT), WSP(bf16_t, WS_GF), WSP(bf16_t, WS_GB), WSP(float, WS_ROPE), WSP(float, WS_LOGG) + j * 8, F.lds};
                gm::gemm_units(F.lds, F.tid, S, E); SEAM(); PE(6); }
            if (SITE(7) && IN(base + 2)) {
                SITE_ENTER(); PB(7);
                const int nn2 = last ? 8 : 20, nu1 = 8 * nn2;
                unsigned* cb = (unsigned*)(F.ws + WS_CTL) + CW_HND + (32 + L * 8) * 64;
                { gm::SchedG S{nullptr, (const char*)WSP(bf16_t, WS_HA), (const char*)(WSP(bf16_t, WS_WRIN) + (size_t)j * 5120 * D), 2048u, 2048u, 16, 0, 20, 8, nn2, 128, last ? 4 : 0, ROWS / 256, ROWS / 256, 0, F.G, c};
                  gm::EpiRetIn E{WSP(bf16_t, WS_Q), WSP(bf16_t, WS_K), WSP(bf16_t, WS_KFT), WSP(bf16_t, WS_KBT), WSP(bf16_t, WS_VT), WSP(bf16_t, WS_GF), WSP(bf16_t, WS_GB), WSP(float, WS_ROPE), WSP(float, WS_LOGG) + j * 8, F.lds};
                  gm::gemm_units(F.lds, F.tid, S, E);
                  if (c < nu1) { int pmc, pnc; gm::tile_order(c, 8, nn2, pmc, pnc); handoff_publish(F, cb + pmc * 64); } }
                { gm::SchedState S{(const char*)WSP(bf16_t, WS_VT), (const char*)WSP(bf16_t, WS_KFT), (const char*)WSP(bf16_t, WS_KBT), (unsigned)TOK * 2u, (unsigned)TOK * 2u, F.G, c, 0, 512, 0};
                  gm::EpiBlk E{WSP(bf16_t, WS_UT)};
                  gm::gemm_units(F.lds, F.tid, S, E); }
                if (c >= nu1 && c < nu1 + 64) { const int Lc = 512 + (c - nu1), q = ((Lc >> 3) >> 1) * 8 + (Lc & 7), bhc = q - 256; handoff_wait(F, cb + (bhc >> 2) * 64, (unsigned)nn2); }
                { gm::SchedState S{(const char*)WSP(bf16_t, WS_VT), (const char*)WSP(bf16_t, WS_KFT), (const char*)WSP(bf16_t, WS_KBT), (unsigned)TOK * 2u, (unsigned)TOK * 2u, F.G, c, 512, 64, nu1};
                  gm::EpiBlk E{WSP(bf16_t, WS_UT)};
                  gm::gemm_units(F.lds, F.tid, S, E); }
                SEAM(); PE(7); }
            if (SITE(9) && IN(base + 4)) {
                SITE_ENTER(); PB(9);
                gm::SchedAtt S{(const char*)WSP(bf16_t, WS_Q), (const char*)WSP(bf16_t, WS_K), 2048u, 2048u, 32 * NX * 4, last ? 0 : 32, F.G, c};
                gm::EpiAtt E{WSP(bf16_t, WS_PF), WSP(bf16_t, WS_PB), WSP(float, WS_LOGG) + j * 8};
                gm::gemm_units(F.lds, F.tid, S, E); ph_prefix(F, P, j); SEAM(); PE(9); }
            if (SITE(10) && IN(base + 5)) {
                SITE_ENTER(); PB(10);
                gm::SchedOut S{(const char*)WSP(bf16_t, WS_Q), (const char*)WSP(bf16_t, WS_ST), (const char*)WSP(bf16_t, WS_PF), (const char*)WSP(bf16_t, WS_PB), (const char*)WSP(bf16_t, WS_VT),
                               2048u, 512u, 512u, (unsigned)TOK * 2u, 4, 32 * NX * 4, last ? 0 : 64, F.G, c};
                gm::EpiOut E{WSP(bf16_t, WS_HA), WSP(bf16_t, WS_GF), WSP(bf16_t, WS_GB), WSP(float, WS_LOGG) + j * 8, F.lds};
                gm::gemm_units(F.lds, F.tid, S, E); SEAM(); PE(10); }
            if (SITE(12) && IN(base + 7)) {
                SITE_ENTER(); PB(12);
                const int nM = 128;
                gm::SchedG S{nullptr, (const char*)WSP(bf16_t, WS_HA), (const char*)(WSP(bf16_t, WS_WROUT) + (size_t)j * D * D), 2048u, 2048u, 16, nM, 4, 0, 0, 0, 0, ROWS / 256, ROWS / 256, 0, F.G, c};
                gm::EpiRes E{P.out, WSP(float, WS_XC), P.out, WSP(float, WS_XC), WSP(float, WS_MOD) + (size_t)L * 9 * NMOD + 2 * D};
                gm::gemm_units(F.lds, F.tid, S, E); SEAM(); PE(12); }
        }
        if (SITE(13) && IN(base + 8)) { SITE_ENTER(); PB(13);
            const bool cx = !last; const bool light = cx && c < 32; int tile = 0, quarter = 0;
            unsigned* ctr = (unsigned*)(F.ws + WS_CTL) + CW_HND;
            if (cx) {
                gm::SchedG S{nullptr, (const char*)WSP(bf16_t, WS_HA), (const char*)((kind1 ? WSP(bf16_t, WS_WROUT) : WSP(bf16_t, WS_WAOUT)) + (size_t)j * D * D), 2048u, 2048u, 16, 0, 4, 8, 4, 128, 0, ROWS / 256, ROWS / 256, 0, F.G, c};
                gm::EpiRes E{(L == 0) ? P.x : P.out, (L == 0) ? P.ctx : WSP(float, WS_XC), P.out, WSP(float, WS_XC), WSP(float, WS_MOD) + (size_t)L * 9 * NMOD + 2 * D};
                gm::gemm_units(F.lds, F.tid, S, E);
                if (light) { gm::tile_order(c, 8, 4, tile, quarter); ctr += (L * 8 + tile) * 64; handoff_publish(F, ctr); }
            }
            if (!light) rt_fill(F, P, L);
            if (!cx) rt_rows<4>(F, P, L, 0, F.vcu * 8 + F.wave, F.G * 8, ROWS_L / (F.G * 8));
            else if (!light) {
                const int fw = (c - 32) * 8 + F.wave, nfw = (F.G - 32) * 8; rt_rows<4>(F, P, L, 0, fw, nfw, (ROWS_L - fw + nfw - 1) / nfw);
                if (F.tid == 0) { unsigned* cb = (unsigned*)(F.ws + WS_CTL) + CW_HND + (L * 8) * 64;
                    for (int t8 = 0; t8 < 8; ++t8) { unsigned sp = 0; while (__hip_atomic_load(cb + t8 * 64, __ATOMIC_RELAXED, __HIP_MEMORY_SCOPE_AGENT) < 4u) { __builtin_amdgcn_s_sleep(2); if (++sp > (1u << 20)) break; } }
                    __builtin_amdgcn_fence(__ATOMIC_ACQUIRE, "agent"); asm volatile("s_waitcnt vmcnt(0)" ::: "memory"); }
                __syncthreads();
                rt_rows<4>(F, P, L, ROWS_L, fw, nfw, (ROWS_C - fw + nfw - 1) / nfw);
            }
            SEAM(); PE(13); }
        if (SITE(14) && IN(base + 9)) { SITE_ENTER(); PB(14); ph_topk(F, last ? 128 : 256); SEAM(); PE(14); }
        {
            const int tpe = last ? 16 : 17;
            if (SITE(16) && IN(base + 11)) {
                SITE_ENTER(); PB(16);
                gm::SchedGT<true> S{WSP(int, WS_IDX), (const char*)WSP(bf16_t, WS_HA), (const char*)WSP(bf16_t, WS_WGU), 2048u, 2048u, 16, NEXP * tpe, 8, 0, 0, 0, 0, tpe, 17, (size_t)2048 * D * 2, F.G, c};
                gm::EpiSwiglu E{WSP(bf16_t, WS_HID)};
                gm::gemm_units(F.lds, F.tid, S, E); SEAM(); PE(16); }
            if (SITE(17) && IN(base + 12)) {
                SITE_ENTER(); PB(17);
                gm::SchedG S{nullptr, (const char*)WSP(bf16_t, WS_HID), (const char*)WSP(bf16_t, WS_WD), 2048u, 2048u, 16, NEXP * tpe, 4, 0, 0, 0, 0, tpe, 17, (size_t)D * D * 2, F.G, c};
                gm::EpiDown E{WSP(bf16_t, WS_YE), WSP(float, WS_GATE)};
                gm::gemm_units(F.lds, F.tid, S, E); SEAM(); PE(17); }
        }
    }
    if (SITE(18) && IN(PH_FINAL)) { SITE_ENTER(); PB(18); ph_final(F, P); PE(18); }
#ifdef PROBE_SITE
    if (blockIdx.x == 0 && threadIdx.x == 0) { const unsigned long long t0 = __builtin_amdgcn_s_memrealtime(), w = probe_acc * PROBE_K; while (__builtin_amdgcn_s_memrealtime() - t0 < w) __builtin_amdgcn_s_sleep(16); }
#endif
#undef IN
#undef SEAM
#undef SITE
#undef SITE_ENTER
}

extern "C" void kernel_launch(void* const* d_in, const int* in_sizes, int n_in, void* d_out, int out_size, void* d_ws, size_t ws_size, hipStream_t stream) {
    static int grid = 0;
    if (grid == 0) {
        if (n_in != 23 || ws_size < WS_END) { fprintf(stderr, "kernel_launch: n_in %d ws %zu (need %zu)\n", n_in, ws_size, (size_t)WS_END); grid = -1; return; }
        int dev = 0, cus = 0;
        if (hipGetDevice(&dev) != hipSuccess || hipDeviceGetAttribute(&cus, hipDeviceAttributeMultiprocessorCount, dev) != hipSuccess) { grid = -1; return; }
        if (hipFuncSetAttribute((const void*)mk_fwd<-1>, hipFuncAttributeMaxDynamicSharedMemorySize, LDS_BYTES) != hipSuccess) { grid = -1; return; }
        (void)hipGetLastError();
        grid = cus & ~7;
    }
    if (grid < 0) return;
    (void)hipMemsetAsync((char*)d_ws + WS_CTL, 0, CTL_ZERO_BYTES, stream);
    Params p{};
    const float** ins = (const float**)&p;
    for (int i = 0; i < 23; ++i) ins[i] = (const float*)d_in[i];
    p.out = (float*)d_out; p.ws = (unsigned char*)d_ws;
    p.ph_lo = 0; p.ph_hi = PH_TOTAL;
    hipLaunchKernelGGL(mk_fwd<-1>, dim3(grid), dim3(512), LDS_BYTES, stream, p);
}
```

```cpp
#include <hip/hip_runtime.h>
#include <cstdio>
#include <cstdint>

#ifndef MK_SINGLE
#define MK_SINGLE 1
#endif

#define LAS __attribute__((address_space(3)))
#define GAS __attribute__((address_space(1)))
typedef unsigned short bf16_t;
typedef short bf16x8 __attribute__((ext_vector_type(8)));
typedef float f32x4 __attribute__((ext_vector_type(4)));
typedef float f32x2 __attribute__((ext_vector_type(2)));
typedef unsigned u32x4 __attribute__((ext_vector_type(4)));
typedef unsigned u32x2 __attribute__((ext_vector_type(2)));

constexpr int D = 1024, NB = 8, SEQ = 4096, CTXL = 256, DEPTH = 4;
constexpr int ROWS_L = NB * SEQ, ROWS_C = NB * CTXL, ROWS = ROWS_L + ROWS_C;
constexpr int NEXP = 16, CAP_L = 512, CAP_C = 32, EROWS = NB * CAP_L + NB * CAP_C;
constexpr int TOK = SEQ + CTXL;
constexpr int NH = 4, DH = 256, SCH = 512, NX = SEQ / SCH;
constexpr float EPS = 1e-6f;
constexpr int NMOD = 6 * D;

constexpr size_t MiB = 1u << 20;
constexpr size_t WS_CTL = 0, CTL_ZERO_BYTES = 65536;
constexpr size_t WS_MOD = 1 * MiB;
constexpr size_t WS_ROPE = 2 * MiB;
constexpr size_t WS_LOGG = 2 * MiB + 65536;
constexpr size_t WS_XC = 3 * MiB;
constexpr size_t WS_AFF = 11 * MiB;
constexpr size_t WS_SLOT = 14 * MiB;
constexpr size_t WS_IDX = 17 * MiB;
constexpr size_t WS_GATE = 17 * MiB + 512 * 1024;
constexpr size_t WS_WAIN = 18 * MiB;
constexpr size_t WS_WAOUT = 26 * MiB;
constexpr size_t WS_WRIN = 30 * MiB;
constexpr size_t WS_WROUT = 50 * MiB;
constexpr size_t WS_WSB = 54 * MiB;
constexpr size_t WS_WGU = 56 * MiB;
constexpr size_t WS_WD = 120 * MiB;
constexpr size_t WS_HA = 152 * MiB;
constexpr size_t WS_BIG = 220 * MiB;
constexpr size_t SZ_ACT = 68 * MiB;
constexpr size_t WS_Q = WS_BIG, WS_K = WS_Q + SZ_ACT, WS_KFT = WS_K + SZ_ACT, WS_KBT = WS_KFT + SZ_ACT, WS_VT = WS_KBT + SZ_ACT, WS_GF = WS_VT + SZ_ACT, WS_GB = WS_GF + SZ_ACT;
constexpr size_t WS_PF = WS_GB + SZ_ACT;
constexpr size_t WS_PB = WS_PF + 100 * MiB;
constexpr size_t WS_XALT = WS_PF;
constexpr size_t WS_UT = WS_PB + 100 * MiB + 72 * MiB;
constexpr size_t WS_ST = WS_PB + 100 * MiB;
constexpr size_t WS_END = WS_UT + 72 * MiB;
constexpr size_t WS_OF = WS_KFT, WS_OB = WS_KBT;
constexpr size_t WS_U = WS_BIG, WS_V = WS_U + SZ_ACT, WS_VT2 = WS_V + SZ_ACT;
constexpr size_t WS_XS = WS_BIG;
constexpr size_t WS_HID = WS_XS + 136 * MiB;
constexpr size_t WS_YE = WS_XS;
constexpr size_t PBLK = 65536;
constexpr size_t P_CTX_OFF = (size_t)32 * NX * 3 * PBLK;

constexpr int CW_BAR = 4096;

constexpr int RING_BYTES = 131072;
constexpr int MISC_OFF = RING_BYTES + 320;
constexpr int TR_OFF = RING_BYTES + 1024;
constexpr int LDS_BYTES = 155648;

#define VM_WAIT() asm volatile("s_waitcnt vmcnt(0)" ::: "memory")
#define LDS_WAIT() asm volatile("s_waitcnt lgkmcnt(0)" ::: "memory")
__device__ __forceinline__ unsigned cvt_pk_bf16(float lo, float hi) { unsigned r; asm volatile("v_cvt_pk_bf16_f32 %0, %1, %2" : "=v"(r) : "v"(lo), "v"(hi)); return r; }
__device__ __forceinline__ float bf_lo(unsigned u) { return __builtin_bit_cast(float, u << 16); }
__device__ __forceinline__ float bf_hi(unsigned u) { return __builtin_bit_cast(float, u & 0xffff0000u); }
__device__ __forceinline__ float bf1(bf16_t u) { return __builtin_bit_cast(float, (unsigned)u << 16); }
__device__ __forceinline__ bf16_t f2bf(float f) { return (bf16_t)(cvt_pk_bf16(f, 0.f) & 0xffffu); }
__device__ __forceinline__ float fexp2(float x) { return __builtin_amdgcn_exp2f(x); }
__device__ __forceinline__ float frcp(float x) { return __builtin_amdgcn_rcpf(x); }
__device__ __forceinline__ float sigmoidf_(float x) { return frcp(1.0f + fexp2(-1.4426950408889634f * x)); }
__device__ __forceinline__ float siluf_(float x) { return x * sigmoidf_(x); }
__device__ __forceinline__ float gelu_tanh(float x) { const float y = 1.5957691216057308f * (x + 0.044715f * x * x * x); return x * sigmoidf_(y); }
__device__ __forceinline__ float wave_sum(float v) {
#pragma unroll
    for (int o = 1; o < 64; o <<= 1) v += __shfl_xor(v, o);
    return v;
}

#define XB_TMO      128
#define XB_XCNT(j)  (256  + 64 * (j))
#define XB_XSUB(j)  (1280 + 64 * (j))
#define XB_XGEN(j)  (2304 + 64 * (j))
#define XB_TOP      3328
#define XB_TOPGEN   3392
#define XCD_BAR_WORDS 3456
#define XB_SPIN_CAP (1u << 18)
__device__ __forceinline__ unsigned xb_ld(unsigned* p)              { return __hip_atomic_load(p, __ATOMIC_RELAXED, __HIP_MEMORY_SCOPE_AGENT); }
__device__ __forceinline__ unsigned xb_add(unsigned* p, unsigned v) { return __hip_atomic_fetch_add(p, v, __ATOMIC_RELAXED, __HIP_MEMORY_SCOPE_AGENT); }
__device__ __forceinline__ unsigned xb_xcc_id() { return (unsigned)__builtin_amdgcn_s_getreg((3 << 11) | 20) & 0xFu; }
#define XB_SPIN(cond, bar) do { unsigned _sp = 0; while (cond) { __builtin_amdgcn_s_sleep(1); \
    if ((++_sp & 255u) == 0u) { if (xb_ld(&(bar)[XB_TMO])) break; if (_sp > XB_SPIN_CAP) { atomicAdd(&(bar)[XB_TMO], 1u); break; } } } } while (0)
struct XcdBarrier { unsigned* bar; unsigned x; volatile LAS unsigned* st; };
__device__ __forceinline__ XcdBarrier xcd_barrier_post(unsigned* bar, volatile LAS unsigned* st) {
    XcdBarrier b; b.bar = bar; b.x = xb_xcc_id(); b.st = st;
    if (threadIdx.x == 0) (void)xb_add(&bar[XB_XCNT(b.x)], 1u);
    return b;
}
__device__ __forceinline__ void xcd_barrier_complete(unsigned* bar, unsigned x, unsigned& nloc, unsigned& nx) {
    const unsigned G = gridDim.x * gridDim.y * gridDim.z;
    unsigned sum, cnt, mine, sp = 0u;
    for (;;) {
        sum = 0u; cnt = 0u; mine = 0u;
#pragma unroll
        for (unsigned j = 0; j < 16; ++j) { const unsigned c = xb_ld(&bar[XB_XCNT(j)]); sum += c; cnt += (c > 0u) ? 1u : 0u; mine = (j == x) ? c : mine; }
        if (sum == G) break;
        __builtin_amdgcn_s_sleep(1);
        if ((++sp & 255u) == 0u) { if (xb_ld(&bar[XB_TMO])) break; if (sp > XB_SPIN_CAP) { atomicAdd(&bar[XB_TMO], 1u); break; } }
    }
    nloc = mine > 0u ? mine : 1u; nx = cnt > 0u ? cnt : 1u;
}
__device__ __forceinline__ void xcd_barrier(const XcdBarrier& b) {
    asm volatile("s_waitcnt vmcnt(0)" ::: "memory");
    __syncthreads();
    if (threadIdx.x == 0) {
        unsigned* bar = b.bar;
        __builtin_amdgcn_s_waitcnt(0);
        unsigned nloc = b.st[0], nx = b.st[1];
        if (nloc == 0u) { xcd_barrier_complete(bar, b.x, nloc, nx); b.st[0] = nloc; b.st[1] = nx; }
        const unsigned old = xb_add(&bar[XB_XSUB(b.x)], 1u);
        const unsigned gen = old / nloc;
        if (old + 1u == (gen + 1u) * nloc) {
            __builtin_amdgcn_fence(__ATOMIC_RELEASE, "agent");
            asm volatile("s_waitcnt vmcnt(0)" ::: "memory");
            const unsigned og = xb_add(&bar[XB_TOP], 1u);
            const unsigned tg = og / nx;
            if (og + 1u == (tg + 1u) * nx) xb_add(&bar[XB_TOPGEN], 1u);
            else XB_SPIN(xb_ld(&bar[XB_TOPGEN]) == tg, bar);
            __builtin_amdgcn_fence(__ATOMIC_ACQUIRE, "agent");
            xb_add(&bar[XB_XGEN(b.x)], 1u);
            asm volatile("s_waitcnt vmcnt(0)" ::: "memory");
        } else {
            XB_SPIN(xb_ld(&bar[XB_XGEN(b.x)]) == gen, bar);
            __builtin_amdgcn_fence(__ATOMIC_ACQUIRE, "agent");
            asm volatile("s_waitcnt vmcnt(0)" ::: "memory");
        }
    }
    __syncthreads();
}

struct Params {
    const float *x, *c, *ctx, *c_ctx, *ada_w, *ada_b, *norm_mix_g, *norm_ffn_g, *a_w_in, *a_ln_g, *a_ln_b, *a_w_s, *a_b_s, *a_w_out,
                *r_w_in, *r_decay_f, *r_decay_b, *r_w_out, *moe_w_router, *moe_w_gate, *moe_w_up, *moe_w_down, *final_norm_g;
    float* out;
    unsigned char* ws;
    int ph_lo, ph_hi;
};

typedef const __attribute__((address_space(4))) Params* KParams;
__device__ __forceinline__ void load_params(Params& P, KParams k) {
    P.x = k->x; P.c = k->c; P.ctx = k->ctx; P.c_ctx = k->c_ctx; P.ada_w = k->ada_w; P.ada_b = k->ada_b; P.norm_mix_g = k->norm_mix_g; P.norm_ffn_g = k->norm_ffn_g;
    P.a_w_in = k->a_w_in; P.a_ln_g = k->a_ln_g; P.a_ln_b = k->a_ln_b; P.a_w_s = k->a_w_s; P.a_b_s = k->a_b_s; P.a_w_out = k->a_w_out; P.r_w_in = k->r_w_in;
    P.r_decay_f = k->r_decay_f; P.r_decay_b = k->r_decay_b; P.r_w_out = k->r_w_out; P.moe_w_router = k->moe_w_router; P.moe_w_gate = k->moe_w_gate; P.moe_w_up = k->moe_w_up;
    P.moe_w_down = k->moe_w_down; P.final_norm_g = k->final_norm_g; P.out = k->out; P.ws = k->ws; P.ph_lo = k->ph_lo; P.ph_hi = k->ph_hi;
}

namespace gm {
constexpr int BM = 256, BK = 64, HALF = 128, HTB = HALF * BK * 2, NXCD = 8, WGM = 4;
__device__ __forceinline__ int lds_byte(int r, int c) { const int st = (r >> 4) * 2 + (c >> 5), rr = r & 15, cc = c & 31, ob = rr * 64 + cc * 2; return st * 1024 + (ob ^ (((ob >> 9) & 1) << 5)); }
__device__ __forceinline__ int perm32(int rho) { const int n = rho >> 4, i = rho & 15; return 8 * (i >> 2) + 4 * n + (i & 3); }
__device__ __forceinline__ void stage_rc(int b, int& R, int& C) { const int st = b / 1024, sb = b % 1024, swz = sb ^ (((sb >> 9) & 1) << 5); R = (st >> 1) * 16 + swz / 64; C = (st & 1) * 32 + (swz % 64) / 2; }

struct Unit { const char* A0; const char* B0; const char* A1; const char* B1; int nt; int i0, i1, i2, i3; };
typedef f32x4 Acc[2][2][4][2];

__device__ __forceinline__ void tile_order(int L, int nM, int nN, int& pm, int& pn) {
    const int nwg = nM * nN; int wgid = L;
    { const int q = nwg / NXCD, r = nwg % NXCD, xcd = wgid % NXCD, off = wgid / NXCD; wgid = (xcd < r ? xcd * (q + 1) : r * (q + 1) + (xcd - r) * q) + off; }
    const int nig = WGM * nN, gid = wgid / nig, fm = gid * WGM, gsz = (nM - fm) < WGM ? (nM - fm) : WGM;
    pm = fm + ((wgid % nig) % gsz); pn = (wgid % nig) / gsz;
}

template <class Epi, class Sched>
__device__ __forceinline__ void gemm_units(LAS unsigned char* lds, const int tid, const Sched& S, const Epi& E) {
    const int wid = __builtin_amdgcn_readfirstlane(tid >> 6), lane = tid & 63, wr = wid >> 2, wc = wid & 3, fr = lane & 15, fq = lane >> 4;
    unsigned sR[2], sRb[2], sC[2];
#pragma unroll
    for (int i = 0; i < 2; ++i) { int R, C; stage_rc(tid * 16 + i * 8192, R, C); sR[i] = (unsigned)R; sC[i] = (unsigned)C * 2u; sRb[i] = Epi::PERM ? (unsigned)((R & ~31) + perm32(R & 31)) : (unsigned)R; }
    const unsigned ldsw = (unsigned)wid * 1024u;
    const int aoff = lds_byte(wr * 64 + fr, fq * 8), boff = lds_byte(wc * 32 + fr, fq * 8);
#define G_SA(b, h) (((b) * 2 + (h)) * HTB)
#define G_SB(b, h) ((4 + (b) * 2 + (h)) * HTB)
#define G_STAGE(bufoff, gbase, ld) do { _Pragma("unroll") for (int _i = 0; _i < 2; ++_i) \
        __builtin_amdgcn_global_load_lds((const unsigned*)((const char*)(gbase) + (sR[_i] * (ld) + sC[_i])), (LAS unsigned*)(lds + (bufoff) + ldsw + _i * 8192), 16, 0, 0); } while (0)
#define G_STAGE_B(bufoff, gbase, ld) do { _Pragma("unroll") for (int _i = 0; _i < 2; ++_i) \
        __builtin_amdgcn_global_load_lds((const unsigned*)((const char*)(gbase) + (sRb[_i] * (ld) + sC[_i])), (LAS unsigned*)(lds + (bufoff) + ldsw + _i * 8192), 16, 0, 0); } while (0)
#define G_STAGE_A(bufoff, abase, ld, h, nx) do { if constexpr (Sched::GATHER) { _Pragma("unroll") for (int _i = 0; _i < 2; ++_i) \
        __builtin_amdgcn_global_load_lds((const unsigned*)((const char*)(abase) + (((nx) ? gn[h][_i] : gc[h][_i]) + sC[_i])), (LAS unsigned*)(lds + (bufoff) + ldsw + _i * 8192), 16, 0, 0); } \
        else { G_STAGE(bufoff, (const char*)(abase) + (size_t)((h) * HALF) * (ld), ld); } } while (0)
#define G_LDA(dst, b, h) do { _Pragma("unroll") for (int m = 0; m < 4; ++m) _Pragma("unroll") for (int k = 0; k < 2; ++k) dst[m][k] = *(const LAS bf16x8*)(lds + G_SA(b, h) + aoff + m * 2048 + k * 1024); } while (0)
#define G_LDB(dst, b, h) do { _Pragma("unroll") for (int n = 0; n < 2; ++n) _Pragma("unroll") for (int k = 0; k < 2; ++k) dst[n][k] = *(const LAS bf16x8*)(lds + G_SB(b, h) + boff + n * 2048 + k * 1024); } while (0)
#define G_MMA(ai, bj, At, Bt) do { __builtin_amdgcn_s_setprio(1); _Pragma("unroll") for (int m = 0; m < 4; ++m) _Pragma("unroll") for (int n = 0; n < 2; ++n) _Pragma("unroll") for (int k = 0; k < 2; ++k) \
        acc[ai][bj][m][n] = __builtin_amdgcn_mfma_f32_16x16x32_bf16(Bt[n][k], At[m][k], acc[ai][bj][m][n], 0, 0, 0); __builtin_amdgcn_s_setprio(0); } while (0)
#define G_WAIT_V(n) asm volatile("s_waitcnt vmcnt(" #n ")" ::: "memory")
#define G_WAIT_L(n) asm volatile("s_waitcnt lgkmcnt(" #n ")" ::: "memory")
#define G_BAR __builtin_amdgcn_s_barrier()
#define G_SCHED __builtin_amdgcn_sched_barrier(0)
    Unit cur, nxt; int ui = 0;
    if (!S.next(0, cur)) return;
    unsigned gc[2][2], gn[2][2];
    if constexpr (Sched::GATHER) {
#pragma unroll
        for (int h = 0; h < 2; ++h)
#pragma unroll
            for (int i = 0; i < 2; ++i) { gc[h][i] = (unsigned)S.gidx[(size_t)cur.i0 * 256 + 128 * h + sR[i]] * S.lda0; gn[h][i] = gc[h][i]; }
    }
    Acc acc;
#pragma unroll
    for (int a = 0; a < 2; ++a)
#pragma unroll
        for (int b = 0; b < 2; ++b)
#pragma unroll
            for (int m = 0; m < 4; ++m)
#pragma unroll
                for (int n = 0; n < 2; ++n) acc[a][b][m][n] = (f32x4){0.f, 0.f, 0.f, 0.f};
    bf16x8 At[4][2], B0[2][2], B1[2][2];
    {
        const char *a0, *b0; unsigned la, lb; S.tile(cur, 0, a0, b0, la, lb);
        const size_t hb = (size_t)HALF * lb;
        G_STAGE_B(G_SB(0, 0), b0, lb); G_STAGE_B(G_SB(0, 1), b0 + hb, lb); G_STAGE_A(G_SA(0, 0), a0, la, 0, false); G_STAGE_A(G_SA(0, 1), a0, la, 1, false);
        if (wr == 1) G_BAR;
        G_WAIT_V(2); G_BAR;
        G_STAGE_B(G_SB(1, 0), b0 + 128, lb); G_STAGE_A(G_SA(1, 0), a0 + 128, la, 0, false); G_STAGE_B(G_SB(1, 1), b0 + hb + 128, lb);
        G_WAIT_V(6); G_BAR;
    }
    for (;;) {
        const bool has_next = S.next(ui + 1, nxt);
        if constexpr (Sched::GATHER) { if (has_next) {
#pragma unroll
            for (int h = 0; h < 2; ++h)
#pragma unroll
                for (int i = 0; i < 2; ++i) gn[h][i] = (unsigned)S.gidx[(size_t)nxt.i0 * 256 + 128 * h + sR[i]] * S.lda0; } }
        const int NT = cur.nt;
#pragma unroll 1
        for (int t = 0; t < NT; t += 2) {
            const bool last = (t == NT - 2);
            const char *a1, *b1_; unsigned la1, lb1; S.tile(cur, t + 1, a1, b1_, la1, lb1);
            const char *a2, *b2; unsigned la2, lb2;
            if (!last) S.tile(cur, t + 2, a2, b2, la2, lb2);
            else if (has_next) S.tile(nxt, 0, a2, b2, la2, lb2);
            else S.tile(cur, 0, a2, b2, la2, lb2);
            const char* a3 = a2 + 128; const char* b3 = b2 + 128;
            const size_t hb2 = (size_t)HALF * lb2;
            if constexpr (Sched::HOOK) { if (t == S.hook_t) E.hook(acc, cur); }
            G_LDB(B0, 0, 0); G_LDB(B1, 0, 1); G_SCHED; G_LDA(At, 0, 0); G_STAGE_A(G_SA(1, 1), a1, la1, 1, false);
            G_WAIT_V(8); G_WAIT_L(0); G_BAR; G_MMA(0, 0, At, B0); G_MMA(0, 1, At, B1); G_BAR; G_SCHED;
            G_LDA(At, 0, 1); G_STAGE_B(G_SB(0, 0), b2, lb2); G_STAGE_B(G_SB(0, 1), b2 + hb2, lb2); G_STAGE_A(G_SA(0, 0), a2, la2, 0, last);
            G_WAIT_V(8); G_WAIT_L(0); G_BAR; G_MMA(1, 0, At, B0); G_MMA(1, 1, At, B1); G_BAR; G_SCHED;
            G_LDB(B0, 1, 0); G_LDB(B1, 1, 1); G_SCHED; G_LDA(At, 1, 0); G_STAGE_A(G_SA(0, 1), a2, la2, 1, last);
            G_WAIT_V(8); G_WAIT_L(0); G_BAR; G_MMA(0, 0, At, B0); G_MMA(0, 1, At, B1); G_BAR; G_SCHED;
            G_LDA(At, 1, 1); G_STAGE_B(G_SB(1, 0), b3, lb2); G_STAGE_B(G_SB(1, 1), b3 + hb2, lb2); G_STAGE_A(G_SA(1, 0), a3, la2, 0, last);
            G_WAIT_V(8); G_WAIT_L(0); G_BAR; G_MMA(1, 0, At, B0); G_MMA(1, 1, At, B1); G_BAR; G_SCHED;
        }
        if (wr == 0) G_BAR;
        E(acc, cur);
        if (!has_next) break;
#pragma unroll
        for (int a = 0; a < 2; ++a)
#pragma unroll
            for (int b = 0; b < 2; ++b)
#pragma unroll
                for (int m = 0; m < 4; ++m)
#pragma unroll
                    for (int n = 0; n < 2; ++n) acc[a][b][m][n] = (f32x4){0.f, 0.f, 0.f, 0.f};
        cur = nxt; ++ui;
        if (wr == 1) G_BAR;
        if constexpr (Sched::GATHER) {
#pragma unroll
            for (int h = 0; h < 2; ++h)
#pragma unroll
                for (int i = 0; i < 2; ++i) gc[h][i] = gn[h][i]; }
    }
    G_WAIT_V(0);
    G_BAR;
#undef G_SA
#undef G_SB
#undef G_STAGE
#undef G_STAGE_A
#undef G_STAGE_B
#undef G_LDA
#undef G_LDB
#undef G_MMA
#undef G_WAIT_V
#undef G_WAIT_L
#undef G_BAR
#undef G_SCHED
}

template <bool GA> struct SchedGT {
    static constexpr bool HOOK = false, GATHER = GA; const int* gidx;
    const char* A; const char* Bt; unsigned lda0, ldb0; int nt;
    int nM, nN;
    int nM2, nN2, pm2, pn2;
    int tpg_eff, tpg_full;
    size_t bgs;
    int G, c;
    __device__ __forceinline__ void tile(const Unit& u, int kt, const char*& a, const char*& b, unsigned& lda, unsigned& ldb) const { a = u.A0 + (size_t)kt * 128; b = u.B0 + (size_t)kt * 128; lda = lda0; ldb = ldb0; }
    __device__ __forceinline__ bool next(int i, Unit& u) const {
        int L = i * G + c; const int n1 = nM * nN;
        int pm, pn;
        if (L < n1) tile_order(L, nM, nN, pm, pn);
        else { L -= n1; if (L >= nM2 * nN2) return false; tile_order(L, nM2, nN2, pm, pn); pm += pm2; pn += pn2; }
        const int e = pm / tpg_eff, pg = e * tpg_full + (pm - e * tpg_eff);
        u.A0 = GA ? A : A + (size_t)pg * 256 * lda0; u.B0 = Bt + (size_t)e * bgs + (size_t)pn * 256 * ldb0; u.nt = nt; u.i0 = pg; u.i1 = pn; u.i2 = e; u.i3 = 0; u.A1 = u.A0; u.B1 = u.B0;
        return true;
    }
};
typedef SchedGT<false> SchedG;
struct SchedState {
    static constexpr bool HOOK = false, GATHER = false;
    const char* VT; const char* KFT; const char* KBT; unsigned lda0, ldb0; int G, c; int u0, nu, coff;
    __device__ __forceinline__ void tile(const Unit& u, int kt, const char*& a, const char*& b, unsigned& lda, unsigned& ldb) const { a = u.A0 + (size_t)kt * 128; b = u.B0 + (size_t)kt * 128; lda = lda0; ldb = ldb0; }
    __device__ __forceinline__ bool next(int i, Unit& u) const {
        const int Lw = i * G + c - coff; if (Lw < 0 || Lw >= nu) return false;
        const int L = u0 + Lw;
        int bh, X, dir;
        { const int xcd = L & 7, jj = L >> 3, q = (jj >> 1) * 8 + xcd; dir = jj & 1;
          if (q < 256) { X = q & 7; bh = q >> 3; } else { X = 8; bh = q - 256; } }
        const size_t off = ((size_t)bh * 256 * TOK + (size_t)X * SCH) * 2;
        u.A0 = VT + off; u.B0 = (dir ? KBT : KFT) + off; u.nt = (X < 8) ? 8 : 4; u.i0 = (bh * 9 + X) * 2 + dir; u.i1 = u.i2 = u.i3 = 0; u.A1 = u.A0; u.B1 = u.B0;
        return true;
    }
};
struct SchedAtt {
    static constexpr bool HOOK = false, GATHER = false;
    const char* Q; const char* K; unsigned lda0, ldb0; int nlat, nctx, G, c;
    __device__ __forceinline__ void tile(const Unit& u, int kt, const char*& a, const char*& b, unsigned& lda, unsigned& ldb) const { a = u.A0 + (size_t)kt * 128; b = u.B0 + (size_t)kt * 128; lda = lda0; ldb = ldb0; }
    __device__ __forceinline__ bool next(int i, Unit& u) const {
        const int L = i * G + c; if (L >= nlat + nctx) return false;
        int bh, X, pm, pn; size_t row0;
        if (L < nlat) { const int xcd = L & 7, jj = L >> 3, q = (jj >> 2) * 8 + xcd; pn = jj & 1; pm = (jj >> 1) & 1; X = q & 7; bh = q >> 3;
            row0 = (size_t)(bh >> 2) * SEQ + (size_t)X * SCH; }
        else { bh = L - nlat; X = 8; pm = pn = 0; row0 = (size_t)ROWS_L + (size_t)(bh >> 2) * CTXL; }
        const size_t hoff = (size_t)(bh & 3) * DH * 2;
        u.A0 = Q + (row0 + pm * 256) * 2048 + hoff; u.B0 = K + (row0 + pn * 256) * 2048 + hoff; u.nt = 4; u.i0 = bh; u.i1 = X; u.i2 = pm; u.i3 = pn; u.A1 = u.A0; u.B1 = u.B0;
        return true;
    }
};
struct SchedOut {
    static constexpr bool HOOK = true, GATHER = false;
    const char* Q; const char* ST; const char* PF; const char* PB; const char* VT;
    unsigned lda0, ldb0, lda1, ldb1; int hook_t; int nlat, nctx, G, c;
    __device__ __forceinline__ void tile(const Unit& u, int kt, const char*& a, const char*& b, unsigned& lda, unsigned& ldb) const {
        const int s = kt >> 2, r = kt & 3;
        if (s == 0) { a = u.A0 + (size_t)r * 128; b = u.B0 + (size_t)r * 128; lda = lda0; ldb = ldb0; }
        else { a = u.A1 + (size_t)(s - 1) * (PBLK * 2) + (size_t)r * 128; b = u.B1 + (size_t)(s - 1) * 512 + (size_t)r * 128; lda = lda1; ldb = ldb1; }
    }
    __device__ __forceinline__ bool next(int i, Unit& u) const {
        const int L = i * G + c; if (L >= nlat + nctx) return false;
        int bh, X, pm, dir; size_t row0;
        if (L < nlat) { const int xcd = L & 7, jj = L >> 3, q = (jj >> 2) * 8 + xcd; dir = jj & 1; pm = (jj >> 1) & 1; X = q & 7; bh = q >> 3;
            row0 = (size_t)(bh >> 2) * SEQ + (size_t)X * SCH; }
        else { const int r = L - nlat, xcd = r & 7, jj = r >> 3; dir = jj & 1; bh = (jj >> 1) * 8 + xcd; X = 8; pm = 0; row0 = (size_t)ROWS_L + (size_t)(bh >> 2) * CTXL; }
        u.A0 = Q + (row0 + pm * 256) * 2048 + (size_t)(bh & 3) * DH * 2;
        u.B0 = ST + (size_t)((bh * 9 + X) * 2 + dir) * PBLK * 2;
        const int nblk = X == 8 ? 1 : (dir ? 2 - pm : pm + 1), kb0 = dir ? pm : 0;
        const size_t pbase = X < 8 ? (size_t)((bh * NX + X) * 3 + pm + kb0) * PBLK : P_CTX_OFF + (size_t)bh * PBLK;
        u.A1 = (dir ? PB : PF) + pbase * 2;
        u.B1 = VT + ((size_t)bh * 256 * TOK + (X < 8 ? (size_t)X * SCH : (size_t)SEQ) + (size_t)kb0 * 256) * 2;
        u.nt = 4 + 4 * nblk; u.i0 = bh; u.i1 = X; u.i2 = pm; u.i3 = dir;
        return true;
    }
};

#define EPI_LANE() int _tz = threadIdx.x; asm volatile("" : "+v"(_tz)); const int wr = _tz >> 8, wc = (_tz >> 6) & 3, fr = _tz & 15, fq = (_tz >> 4) & 3
#define EPI_ROWS(ai, m) (128 * (ai) + 64 * wr + 16 * (m) + fr)
#define EPI_COLS(bj, n) (128 * (bj) + 32 * wc + 16 * (n) + 4 * fq)
#define EPI_COL8(bj) (128 * (bj) + 32 * wc + 8 * fq)
__device__ __forceinline__ void st_bf8(bf16_t* p, const f32x4 a, const f32x4 b) { u32x4 w; w.x = cvt_pk_bf16(a[0], a[1]); w.y = cvt_pk_bf16(a[2], a[3]); w.z = cvt_pk_bf16(b[0], b[1]); w.w = cvt_pk_bf16(b[2], b[3]); *(u32x4*)p = w; }
__device__ __forceinline__ void st_bf8_wt(bf16_t* p, const f32x4 a, const f32x4 b) { u32x4 w; w.x = cvt_pk_bf16(a[0], a[1]); w.y = cvt_pk_bf16(a[2], a[3]); w.z = cvt_pk_bf16(b[0], b[1]); w.w = cvt_pk_bf16(b[2], b[3]);
    asm volatile("global_store_dwordx4 %0, %1, off sc1\n\ts_nop 1" :: "v"(p), "v"(w) : "memory"); }
__device__ __forceinline__ void st_bf4(bf16_t* p, const f32x4 v) { u32x2 w; w.x = cvt_pk_bf16(v[0], v[1]); w.y = cvt_pk_bf16(v[2], v[3]); *(u32x2*)p = w; }

__device__ __forceinline__ float dpp_q1(float v) { return __builtin_bit_cast(float, __builtin_amdgcn_mov_dpp(__builtin_bit_cast(int, v), 0xB1, 0xF, 0xF, true)); }
__device__ __forceinline__ float dpp_q2(float v) { return __builtin_bit_cast(float, __builtin_amdgcn_mov_dpp(__builtin_bit_cast(int, v), 0x4E, 0xF, 0xF, true)); }
__device__ __forceinline__ f32x4 quad_transpose(const f32x4 x, const bool odd, const bool hi) {
    const float s0 = odd ? x[0] : x[1], s1 = odd ? x[2] : x[3]; const float r0 = dpp_q1(s0), r1 = dpp_q1(s1);
    const float a0 = odd ? r0 : x[0], a1 = odd ? x[1] : r0, a2 = odd ? r1 : x[2], a3 = odd ? x[3] : r1;
    const float t0 = hi ? a0 : a2, t1 = hi ? a1 : a3; const float q0 = dpp_q2(t0), q1 = dpp_q2(t1);
    return (f32x4){hi ? q0 : a0, hi ? q1 : a1, hi ? a2 : q0, hi ? a3 : q1};
}
struct EpiGelu {           static constexpr bool PERM = true;
    bf16_t* U; bf16_t* V; float* LNP;
    __device__ __forceinline__ void operator()(const Acc& acc, const Unit& u) const { EPI_LANE();
        const bool isv = u.i1 >= 4;
        bf16_t* dst = (isv ? V : U) + (size_t)u.i0 * 256 * D + (u.i1 & 3) * 256;
#pragma unroll
        for (int ai = 0; ai < 2; ++ai)
#pragma unroll
            for (int m = 0; m < 4; ++m) { const int row = EPI_ROWS(ai, m); bf16_t* rp = dst + (size_t)row * D; float sm = 0.f, sq = 0.f;
#pragma unroll
                for (int bj = 0; bj < 2; ++bj) { f32x4 g[2];
#pragma unroll
                    for (int n = 0; n < 2; ++n) { const f32x4 a = acc[ai][bj][m][n]; g[n] = (f32x4){gelu_tanh(a[0]), gelu_tanh(a[1]), gelu_tanh(a[2]), gelu_tanh(a[3])};
                        sm += (g[n][0] + g[n][1]) + (g[n][2] + g[n][3]); sq += (g[n][0] * g[n][0] + g[n][1] * g[n][1]) + (g[n][2] * g[n][2] + g[n][3] * g[n][3]); }
                    st_bf8(rp + EPI_COL8(bj), g[0], g[1]); }
                if (isv) { sm += __shfl_xor(sm, 16); sq += __shfl_xor(sq, 16); sm += __shfl_xor(sm, 32); sq += __shfl_xor(sq, 32);
                    if (fq == 0) *(f32x2*)(LNP + (((size_t)u.i0 * 256 + row) * 16 + (u.i1 - 4) * 4 + wc) * 2) = (f32x2){sm, sq}; } }
    }
};
struct EpiRes {            static constexpr bool PERM = true;
    const float* x32_l; const float* x32_c;
    const bf16_t* xs_l; const bf16_t* xs_c; bf16_t* xd_l; bf16_t* xd_c; const float* gate;
    bool wt;
    __device__ __forceinline__ void operator()(const Acc& acc, const Unit& u) const { EPI_LANE();
        const int pm = u.i0, pn = u.i1; const bool lat = pm < 128; const bool first = x32_l != nullptr;
        const size_t po = (size_t)(lat ? pm : pm - 128) * 256 * D + pn * 256;
        const float* src32 = (lat ? x32_l : x32_c) + po;
        const bf16_t* src = (lat ? xs_l : xs_c) + po;
        bf16_t* dst = (lat ? xd_l : xd_c) + po;
        const float* gp = gate + (size_t)(lat ? (pm >> 4) : 8) * NMOD + pn * 256;
        f32x4 gv[2][2];
#pragma unroll
        for (int bj = 0; bj < 2; ++bj)
#pragma unroll
            for (int n = 0; n < 2; ++n) gv[bj][n] = *(const f32x4*)(gp + EPI_COL8(bj) + 4 * n);
#pragma unroll
        for (int ai = 0; ai < 2; ++ai)
#pragma unroll
            for (int m = 0; m < 4; ++m) { const size_t ro = (size_t)EPI_ROWS(ai, m) * D;
#pragma unroll
                for (int bj = 0; bj < 2; ++bj) { const int co = EPI_COL8(bj); f32x4 x0, x1;
                    if (first) { x0 = *(const f32x4*)(src32 + ro + co); x1 = *(const f32x4*)(src32 + ro + co + 4); }
                    else { const u32x4 w = *(const u32x4*)(src + ro + co); x0 = (f32x4){bf_lo(w.x), bf_hi(w.x), bf_lo(w.y), bf_hi(w.y)}; x1 = (f32x4){bf_lo(w.z), bf_hi(w.z), bf_lo(w.w), bf_hi(w.w)}; }
                    if (wt) st_bf8_wt(dst + ro + co, x0 + gv[bj][0] * acc[ai][bj][m][0], x1 + gv[bj][1] * acc[ai][bj][m][1]);
                    else st_bf8(dst + ro + co, x0 + gv[bj][0] * acc[ai][bj][m][0], x1 + gv[bj][1] * acc[ai][bj][m][1]); } }
    }
};
struct EpiRetIn {          static constexpr bool PERM = true;
    bf16_t *Q, *K, *KFT, *KBT, *VT, *GF, *GB; const float* rope; const float* logg; LAS unsigned char* lds;
    __device__ __forceinline__ void operator()(const Acc& acc, const Unit& u) const { EPI_LANE();
        const int pm = u.i0, pn = u.i1, part = pn >> 2, h = pn & 3; const bool lat = pm < 128;
        const int b = lat ? (pm >> 4) : (pm - 128), n0 = lat ? (pm & 15) * 256 : 0;
        const size_t grow0 = (size_t)pm * 256;
        LAS bf16_t* T = (LAS bf16_t*)(lds + TR_OFF + (_tz >> 6) * 2304);
        const int cr = (_tz >> 2) & 15, tq = _tz & 3;
        const size_t tbase = ((size_t)(b * NH + h) * DH) * TOK + (lat ? 0 : SEQ);
        if (part == 0 || part == 1) {
            const float sc = part == 1 ? 0.0625f : 1.0f;
            bf16_t* dst = (part == 0 ? Q : K) + grow0 * D + h * DH;
            const float l2f = logg[h], l2b = logg[4 + h];
#pragma unroll
            for (int ai = 0; ai < 2; ++ai) {
                const int tr0 = n0 + 128 * ai + 64 * wr + 16 * tq;
                float dfr[16], dbr[16];
                if (part == 1) { const int nl0 = lat ? (tr0 & (SCH - 1)) : tr0, len = lat ? SCH : CTXL;
#pragma unroll
                    for (int i = 0; i < 16; ++i) { dfr[i] = fexp2(l2f * (float)(len - 1 - nl0 - i)); dbr[i] = fexp2(l2b * (float)(nl0 + i)); } }
#pragma unroll
                for (int nn = 0; nn < 2; ++nn) {
                    const int i0 = 32 * wc + 8 * fq + 4 * nn;
                    f32x4 o1[4], o2[4];
#pragma unroll
                    for (int m = 0; m < 4; ++m) {
                        const int row = EPI_ROWS(ai, m), n = n0 + row;
                        const int pos = (wc < 2) ? (n >> 6) : (n & 63);
                        const f32x4 t1 = acc[ai][0][m][nn] * sc, t2 = acc[ai][1][m][nn] * sc;
                        if (lat) {
#pragma unroll
                            for (int j = 0; j < 4; ++j) { const f32x2 cs = *(const f32x2*)(rope + ((size_t)pos * 64 + ((i0 + j) & 63)) * 2);
                                o1[m][j] = t1[j] * cs.x - t2[j] * cs.y; o2[m][j] = t1[j] * cs.y + t2[j] * cs.x; }
                        } else { o1[m] = t1; o2[m] = t2; }
                        bf16_t* rp = dst + (size_t)row * D;
                        st_bf4(rp + i0, o1[m]); st_bf4(rp + 128 + i0, o2[m]);
                    }
                    if (part == 1) {
#pragma unroll
                        for (int half = 0; half < 2; ++half) {
                            asm volatile("" ::: "memory");
#pragma unroll
                            for (int m = 0; m < 4; ++m)
#pragma unroll
                                for (int j = 0; j < 4; ++j) T[(4 * fq + j) * 72 + 16 * m + fr] = f2bf(half ? o2[m][j] : o1[m][j]);
                            asm volatile("" ::: "memory");
                            const u32x4 r0 = *(const LAS u32x4*)(T + cr * 72 + tq * 16), r1 = *(const LAS u32x4*)(T + cr * 72 + tq * 16 + 8);
                            asm volatile("" ::: "memory");
                            const int col = half * 128 + 32 * wc + 8 * (cr >> 2) + 4 * nn + (cr & 3);
                            const size_t to = tbase + (size_t)col * TOK + (size_t)tr0;
                            float vv[16];
#pragma unroll
                            for (int k = 0; k < 4; ++k) { vv[2 * k] = bf_lo(r0[k]); vv[2 * k + 1] = bf_hi(r0[k]); vv[8 + 2 * k] = bf_lo(r1[k]); vv[8 + 2 * k + 1] = bf_hi(r1[k]); }
                            st_bf8(KFT + to, (f32x4){vv[0] * dfr[0], vv[1] * dfr[1], vv[2] * dfr[2], vv[3] * dfr[3]}, (f32x4){vv[4] * dfr[4], vv[5] * dfr[5], vv[6] * dfr[6], vv[7] * dfr[7]});
                            st_bf8(KFT + to + 8, (f32x4){vv[8] * dfr[8], vv[9] * dfr[9], vv[10] * dfr[10], vv[11] * dfr[11]}, (f32x4){vv[12] * dfr[12], vv[13] * dfr[13], vv[14] * dfr[14], vv[15] * dfr[15]});
                            st_bf8(KBT + to, (f32x4){vv[0] * dbr[0], vv[1] * dbr[1], vv[2] * dbr[2], vv[3] * dbr[3]}, (f32x4){vv[4] * dbr[4], vv[5] * dbr[5], vv[6] * dbr[6], vv[7] * dbr[7]});
                            st_bf8(KBT + to + 8, (f32x4){vv[8] * dbr[8], vv[9] * dbr[9], vv[10] * dbr[10], vv[11] * dbr[11]}, (f32x4){vv[12] * dbr[12], vv[13] * dbr[13], vv[14] * dbr[14], vv[15] * dbr[15]});
                        }
                    }
                }
            }
        } else if (part == 2) {
#pragma unroll
            for (int ai = 0; ai < 2; ++ai) { const size_t tr0 = (size_t)(n0 + 128 * ai + 64 * wr + 16 * tq);
#pragma unroll
                for (int bj = 0; bj < 2; ++bj)
#pragma unroll
                    for (int nn = 0; nn < 2; ++nn) {
                        asm volatile("" ::: "memory");
#pragma unroll
                        for (int m = 0; m < 4; ++m)
#pragma unroll
                            for (int j = 0; j < 4; ++j) T[(4 * fq + j) * 72 + 16 * m + fr] = f2bf(acc[ai][bj][m][nn][j]);
                        asm volatile("" ::: "memory");
                        const u32x4 r0 = *(const LAS u32x4*)(T + cr * 72 + tq * 16), r1 = *(const LAS u32x4*)(T + cr * 72 + tq * 16 + 8);
                        asm volatile("" ::: "memory");
                        const int col = 128 * bj + 32 * wc + 8 * (cr >> 2) + 4 * nn + (cr & 3);
                        bf16_t* vp = VT + tbase + (size_t)col * TOK + tr0;
                        *(u32x4*)vp = r0; *(u32x4*)(vp + 8) = r1; } }
        } else {
            bf16_t* dst = (part == 3 ? GF : GB) + grow0 * D + h * DH;
#pragma unroll
            for (int ai = 0; ai < 2; ++ai)
#pragma unroll
                for (int m = 0; m < 4; ++m) { bf16_t* rp = dst + (size_t)EPI_ROWS(ai, m) * D;
#pragma unroll
                    for (int bj = 0; bj < 2; ++bj) { const f32x4 a = acc[ai][bj][m][0], b2 = acc[ai][bj][m][1];
                        st_bf8(rp + EPI_COL8(bj), (f32x4){siluf_(a[0]), siluf_(a[1]), siluf_(a[2]), siluf_(a[3])}, (f32x4){siluf_(b2[0]), siluf_(b2[1]), siluf_(b2[2]), siluf_(b2[3])}); } }
        }
    }
};
struct EpiBlk {            static constexpr bool PERM = true;
    bf16_t* C;
    __device__ __forceinline__ void operator()(const Acc& acc, const Unit& u) const { EPI_LANE();
        bf16_t* dst = C + (size_t)u.i0 * PBLK;
#pragma unroll
        for (int ai = 0; ai < 2; ++ai)
#pragma unroll
            for (int m = 0; m < 4; ++m) { bf16_t* rp = dst + (size_t)EPI_ROWS(ai, m) * 256;
#pragma unroll
                for (int bj = 0; bj < 2; ++bj) st_bf8(rp + EPI_COL8(bj), acc[ai][bj][m][0], acc[ai][bj][m][1]); }
    }
};
struct EpiAtt {            static constexpr bool PERM = true;
    bf16_t* PF; bf16_t* PB; const float* logg;
    template <int DIR> __device__ __forceinline__ void one(const Acc& acc, bf16_t* dst, const float sg, const bool diag, const int dlt, int wr, int wc, int fr, int fq) const {
        float cf[2][2][4];
#pragma unroll
        for (int bj = 0; bj < 2; ++bj)
#pragma unroll
            for (int n = 0; n < 2; ++n)
#pragma unroll
                for (int j = 0; j < 4; ++j) cf[bj][n][j] = fexp2(-sg * (float)(EPI_COL8(bj) + 4 * n + j));
#pragma unroll
        for (int ai = 0; ai < 2; ++ai)
#pragma unroll
            for (int m = 0; m < 4; ++m) { const int row = EPI_ROWS(ai, m); const float rf = fexp2(sg * (float)(row + dlt));
                bf16_t* rp = dst + (size_t)row * 256;
#pragma unroll
                for (int bj = 0; bj < 2; ++bj) { f32x4 v[2];
#pragma unroll
                    for (int n = 0; n < 2; ++n) { const int c0 = EPI_COL8(bj) + 4 * n;
#pragma unroll
                        for (int j = 0; j < 4; ++j) { float w = acc[ai][bj][m][n][j] * (rf * cf[bj][n][j]);
                            if (diag) { const int sd = DIR ? (c0 + j) - row : row - (c0 + j) + 1; w *= (float)min(max(sd, 0), 1); }
                            v[n][j] = w; } }
                    st_bf8(rp + EPI_COL8(bj), v[0], v[1]); }
                __builtin_amdgcn_sched_barrier(0); }
    }
    __device__ __forceinline__ void operator()(const Acc& acc, const Unit& u) const { EPI_LANE();
        const int bh = u.i0, X = u.i1, pm = u.i2, pn = u.i3, h = bh & 3;
        const size_t base = (X < 8 ? (size_t)((bh * NX + X) * 3) * PBLK : P_CTX_OFF + (size_t)bh * PBLK) + (size_t)(pm + pn) * PBLK;
        const bool diag = pm == pn; const int dlt = (pm - pn) * 256;
        if (pn <= pm) one<0>(acc, PF + base, logg[h], diag, dlt, wr, wc, fr, fq);
        if (pn >= pm) one<1>(acc, PB + base, -logg[4 + h], diag, dlt, wr, wc, fr, fq);
    }
};
struct EpiOut {            static constexpr bool PERM = true;
    bf16_t* OF; bf16_t* OB; const float* logg;
    __device__ __forceinline__ void hook(Acc& acc, const Unit& u) const { EPI_LANE();
        const int h = u.i0 & 3, pm = u.i2, dir = u.i3; const float l2 = logg[dir * 4 + h];
#pragma unroll
        for (int ai = 0; ai < 2; ++ai)
#pragma unroll
            for (int m = 0; m < 4; ++m) { const int nl = pm * 256 + EPI_ROWS(ai, m); const float d = fexp2(l2 * (float)(dir == 0 ? nl + 1 : SCH - nl));
#pragma unroll
                for (int bj = 0; bj < 2; ++bj)
#pragma unroll
                    for (int n = 0; n < 2; ++n) acc[ai][bj][m][n] *= d; }
    }
    __device__ __forceinline__ void operator()(const Acc& acc, const Unit& u) const { EPI_LANE();
        const int bh = u.i0, X = u.i1, pm = u.i2, dir = u.i3;
        const size_t row0 = (X < 8 ? (size_t)(bh >> 2) * SEQ + (size_t)X * SCH : (size_t)ROWS_L + (size_t)(bh >> 2) * CTXL) + pm * 256;
        bf16_t* dst = (dir ? OB : OF) + row0 * D + (bh & 3) * DH;
#pragma unroll
        for (int ai = 0; ai < 2; ++ai)
#pragma unroll
            for (int m = 0; m < 4; ++m) { bf16_t* rp = dst + (size_t)EPI_ROWS(ai, m) * D;
#pragma unroll
                for (int bj = 0; bj < 2; ++bj) st_bf8(rp + EPI_COL8(bj), acc[ai][bj][m][0], acc[ai][bj][m][1]); }
    }
};
struct EpiSwiglu {         static constexpr bool PERM = true;
    bf16_t* HID;
    __device__ __forceinline__ void operator()(const Acc& acc, const Unit& u) const { EPI_LANE();
        bf16_t* dst = HID + (size_t)u.i0 * 256 * D + u.i1 * 128;
#pragma unroll
        for (int ai = 0; ai < 2; ++ai)
#pragma unroll
            for (int m = 0; m < 4; ++m) { bf16_t* rp = dst + (size_t)EPI_ROWS(ai, m) * D;
                { f32x4 hv[2];
#pragma unroll
                  for (int n = 0; n < 2; ++n) { const f32x4 g = acc[ai][0][m][n], w = acc[ai][1][m][n]; hv[n] = (f32x4){siluf_(g[0]) * w[0], siluf_(g[1]) * w[1], siluf_(g[2]) * w[2], siluf_(g[3]) * w[3]}; }
                  st_bf8(rp + 32 * wc + 8 * fq, hv[0], hv[1]); } }
    }
};
struct EpiDown {           static constexpr bool PERM = true;
    bf16_t* YE; const float* gate;
    __device__ __forceinline__ void operator()(const Acc& acc, const Unit& u) const { EPI_LANE();
        bf16_t* dst = YE + (size_t)u.i0 * 256 * D + u.i1 * 256;
#pragma unroll
        for (int ai = 0; ai < 2; ++ai)
#pragma unroll
            for (int m = 0; m < 4; ++m) { const int row = EPI_ROWS(ai, m); bf16_t* rp = dst + (size_t)row * D;
#pragma unroll
                for (int bj = 0; bj < 2; ++bj) st_bf8(rp + EPI_COL8(bj), acc[ai][bj][m][0], acc[ai][bj][m][1]); }
    }
};
}

struct Frame {
    LAS unsigned char* lds; int tid, lane, wave, vcu, G, bx;
    unsigned char* ws;
};
__device__ __forceinline__ void frame_init(Frame& F, LAS unsigned char* lds) {
    int tz = threadIdx.x, bz = blockIdx.x, gz = gridDim.x;
    asm volatile("" : "+v"(tz)); asm volatile("" : "+s"(bz)); asm volatile("" : "+s"(gz));
    F.lds = lds; F.tid = tz; F.lane = tz & 63; F.wave = __builtin_amdgcn_readfirstlane(tz >> 6); F.G = gz; F.bx = bz;
    F.vcu = (gz % 8 == 0) ? (bz % 8) * (gz / 8) + bz / 8 : bz; F.ws = nullptr;
}
#define WSP(T, off) ((T*)(F.ws + (off)))

__device__ __forceinline__ void ph_mod(const Frame& F, const Params& p) {
    LAS float* sc = (LAS float*)F.lds;
    LAS float* part = (LAS float*)(F.lds + 36864);
    for (int idx = F.tid; idx < 9 * D; idx += 512) { const int m = idx >> 10, k = idx & 1023; const float v = m < 8 ? p.c[m * D + k] : p.c_ctx[k]; sc[idx] = siluf_(v); }
    __syncthreads();
    float* MOD = WSP(float, WS_MOD);
    for (int t = F.vcu; t < 4 * 48; t += F.G) {
        const int L = t / 48, cb = t % 48;
        f32x4 acc[9];
#pragma unroll
        for (int m = 0; m < 9; ++m) acc[m] = (f32x4){0.f, 0.f, 0.f, 0.f};
        const int ks = F.lane >> 5, cg = F.lane & 31;
        const float* wp = p.ada_w + ((size_t)L * D + F.wave * 128 + ks) * NMOD + cb * 128 + cg * 4;
#pragma unroll 8
        for (int kk = 0; kk < 64; ++kk) {
            const f32x4 w = __builtin_nontemporal_load((const f32x4*)(wp + (size_t)(2 * kk) * NMOD));
#pragma unroll
            for (int m = 0; m < 9; ++m) acc[m] += w * sc[m * D + F.wave * 128 + 2 * kk + ks];
        }
#pragma unroll
        for (int m = 0; m < 9; ++m) {
#pragma unroll
            for (int q = 0; q < 4; ++q) acc[m][q] += __shfl_xor(acc[m][q], 32);
            if (ks == 0) *(LAS f32x4*)(part + (F.wave * 9 + m) * 128 + cg * 4) = acc[m]; }
        __syncthreads();
        for (int idx = F.tid; idx < 9 * 128; idx += 512) { const int m = idx >> 7, col = idx & 127; float s = 0.f;
#pragma unroll
            for (int w = 0; w < 8; ++w) s += part[(w * 9 + m) * 128 + col];
            MOD[((size_t)L * 9 + m) * NMOD + cb * 128 + col] = s + p.ada_b[(size_t)L * NMOD + cb * 128 + col]; }
        __syncthreads();
    }
}
__device__ __forceinline__ void ph_tables(const Frame& F, const Params& p) {
    if (F.vcu == F.G - 1) {
        float* rope = WSP(float, WS_ROPE);
        for (int idx = F.tid; idx < 64 * 64; idx += 512) { const int pos = idx >> 6, j = idx & 63;
            const float inv = fexp2(-(float)j * (13.287712379549449f / 64.0f));
            const float ang = (float)pos * inv; float rev = ang * 0.15915494309189535f; rev -= floorf(rev);
            rope[idx * 2] = __builtin_amdgcn_cosf(rev); rope[idx * 2 + 1] = __builtin_amdgcn_sinf(rev); }
        float* logg = WSP(float, WS_LOGG);
        if (F.tid < 16) { const int j = F.tid >> 3, dir = (F.tid >> 2) & 1, h = F.tid & 3; const float x = (dir ? p.r_decay_b : p.r_decay_f)[j * 4 + h];
            logg[F.tid] = -log1pf(expf(-x)) * 1.4426950408889634f; }
    }
}
__device__ __forceinline__ void tr_item(const float* W, int K, int N, bf16_t* WT, int k0, int n0, int out_row0, LAS float* scr, int lane) {
#pragma unroll 8
    for (int i = 0; i < 32; ++i) { const int kk = 2 * i + (lane >> 5); scr[kk * 33 + (lane & 31)] = W[(size_t)(k0 + kk) * N + n0 + (lane & 31)]; }
    LDS_WAIT(); asm volatile("" ::: "memory");
    const int c = lane & 7;
#pragma unroll
    for (int j = 0; j < 4; ++j) { const int n = (lane >> 3) + 8 * j; const LAS float* s = scr + (8 * c) * 33 + n;
        u32x4 o; o.x = cvt_pk_bf16(s[0 * 33], s[1 * 33]); o.y = cvt_pk_bf16(s[2 * 33], s[3 * 33]); o.z = cvt_pk_bf16(s[4 * 33], s[5 * 33]); o.w = cvt_pk_bf16(s[6 * 33], s[7 * 33]);
        *(u32x4*)(WT + (size_t)(out_row0 + n) * K + k0 + 8 * c) = o; }
    LDS_WAIT(); asm volatile("" ::: "memory");
}
__device__ __forceinline__ void tr_item16(const float* W, int K, int N, bf16_t* WT, int k0, int n0, int out_row0, LAS float* scr, int lane) {
    const int c4 = (lane & 15) * 4, r4 = lane >> 4;
#pragma unroll
    for (int i = 0; i < 8; ++i) { const int kk = 4 * i + r4; *(LAS f32x4*)(scr + kk * 68 + c4) = __builtin_nontemporal_load((const f32x4*)(W + (size_t)(k0 + kk) * N + n0 + c4)); }
    LDS_WAIT(); asm volatile("" ::: "memory");
    const int kq = lane & 3;
#pragma unroll
    for (int pss = 0; pss < 4; ++pss) { const int n = (lane >> 2) + 16 * pss; const LAS float* sp = scr + (8 * kq) * 68 + n;
        u32x4 o; o.x = cvt_pk_bf16(sp[0 * 68], sp[1 * 68]); o.y = cvt_pk_bf16(sp[2 * 68], sp[3 * 68]); o.z = cvt_pk_bf16(sp[4 * 68], sp[5 * 68]); o.w = cvt_pk_bf16(sp[6 * 68], sp[7 * 68]);
        *(u32x4*)(WT + (size_t)(out_row0 + n) * K + k0 + 8 * kq) = o; }
    LDS_WAIT(); asm volatile("" ::: "memory");
}
constexpr int WC_IPM = 32 * 16;
constexpr int WC_NGU = NEXP * 2 * WC_IPM, WC_NALL = NEXP * 3 * WC_IPM;
constexpr int WD_EARLY = 4096;
constexpr int WC_EARLY = 8192;
template <class Dec>
__device__ __forceinline__ void wc_loop(const Frame& F, const Dec& dec, int i0, int i1, int gw, int NGW) {
    LAS float* scr = (LAS float*)(F.lds + F.wave * 8704);
    const int c4 = (F.lane & 15) * 4, r4 = F.lane >> 4, kq = F.lane & 3;
    f32x4 nx[8]; bf16_t* dn = nullptr;
#define WC_LOAD(it_) do { const float* s_; int N_; dec((it_), s_, N_, dn); _Pragma("unroll") for (int i = 0; i < 8; ++i) nx[i] = __builtin_nontemporal_load((const f32x4*)(s_ + (size_t)(4 * i + r4) * N_ + c4)); } while (0)
#pragma unroll
    for (int i = 0; i < 8; ++i) nx[i] = (f32x4){0.f, 0.f, 0.f, 0.f};
    if (i0 + gw < i1) WC_LOAD(i0 + gw);
    for (int it = i0 + gw; it < i1; it += NGW) {
        bf16_t* dc = dn;
#pragma unroll
        for (int i = 0; i < 8; ++i) *(LAS f32x4*)(scr + (4 * i + r4) * 68 + c4) = nx[i];
        if (it + NGW < i1) WC_LOAD(it + NGW);
        LDS_WAIT(); asm volatile("" ::: "memory");
#pragma unroll
        for (int pss = 0; pss < 4; ++pss) { const int n = (F.lane >> 2) + 16 * pss; const LAS float* sp = scr + (8 * kq) * 68 + n;
            u32x4 o; o.x = cvt_pk_bf16(sp[0 * 68], sp[1 * 68]); o.y = cvt_pk_bf16(sp[2 * 68], sp[3 * 68]); o.z = cvt_pk_bf16(sp[4 * 68], sp[5 * 68]); o.w = cvt_pk_bf16(sp[6 * 68], sp[7 * 68]);
            *(u32x4*)(dc + (size_t)n * D + 8 * kq) = o; }
        LDS_WAIT(); asm volatile("" ::: "memory");
    }
#undef WC_LOAD
}
__device__ __forceinline__ bf16_t* wd_buf(const Params& p, unsigned char* ws, int L) { return (L & 1) ? (bf16_t*)((unsigned char*)p.out + 64 * MiB) : (bf16_t*)(ws + WS_WD); }
struct DecMoe { const Params* p; unsigned char* ws; int L;
    __device__ __forceinline__ void operator()(int it, const float*& src, int& N, bf16_t*& dst) const { N = D;
        if (it < WC_NGU) { const int e = it / (2 * WC_IPM), r = it % (2 * WC_IPM), which = r / WC_IPM, q = r % WC_IPM, nb = q % 16, kb = q / 16, n0 = nb * 64;
            src = (which == 0 ? p->moe_w_gate : p->moe_w_up) + ((size_t)L * NEXP + e) * D * D + (size_t)(kb * 32) * D + n0;
            dst = (bf16_t*)(ws + WS_WGU) + (size_t)e * 2048 * D + (size_t)((n0 >> 7) * 256 + (n0 & 127) + which * 128) * D + kb * 32; }
        else { const int r = it - WC_NGU, e = r / WC_IPM, q = r % WC_IPM, nb = q % 16, kb = q / 16, n0 = nb * 64;
            src = p->moe_w_down + ((size_t)L * NEXP + e) * D * D + (size_t)(kb * 32) * D + n0;
            dst = wd_buf(*p, ws, L) + (size_t)e * D * D + (size_t)n0 * D + kb * 32; } }
};
__device__ __forceinline__ void ph_wconv_moe(const Frame& F, const Params& p, int L, int i0, int i1, int gw, int NGW) { DecMoe dec{&p, F.ws, L}; wc_loop(F, dec, i0, i1, gw, NGW); }
struct DecSmall { const Params* p; unsigned char* ws;
    static constexpr int I_AIN = 32 * 32, I_AOUT = 32 * 16, I_RIN = 32 * 80, I_ROUT = 32 * 16, NIT = 2 * (I_AIN + I_AOUT + I_RIN + I_ROUT);
    __device__ __forceinline__ void operator()(int it, const float*& src, int& N, bf16_t*& dst) const {
        int r = it; const int j = r & 1; r >>= 1;
        if (r < I_AIN) { const int nb = r % 32, kb = r / 32; N = 2048; src = p->a_w_in + (size_t)j * D * 2048 + (size_t)(kb * 32) * 2048 + nb * 64; dst = (bf16_t*)(ws + WS_WAIN) + (size_t)j * 2048 * D + (size_t)(nb * 64) * D + kb * 32; return; } r -= I_AIN;
        if (r < I_AOUT) { const int nb = r % 16, kb = r / 16; N = D; src = p->a_w_out + (size_t)j * D * D + (size_t)(kb * 32) * D + nb * 64; dst = (bf16_t*)(ws + WS_WAOUT) + (size_t)j * D * D + (size_t)(nb * 64) * D + kb * 32; return; } r -= I_AOUT;
        if (r < I_RIN) { const int nb = r % 80, kb = r / 80; N = 5120; src = p->r_w_in + (size_t)j * D * 5120 + (size_t)(kb * 32) * 5120 + nb * 64; dst = (bf16_t*)(ws + WS_WRIN) + (size_t)j * 5120 * D + (size_t)(nb * 64) * D + kb * 32; return; } r -= I_RIN;
        { const int nb = r % 16, kb = r / 16; N = D; src = p->r_w_out + (size_t)j * D * D + (size_t)(kb * 32) * D + nb * 64; dst = (bf16_t*)(ws + WS_WROUT) + (size_t)j * D * D + (size_t)(nb * 64) * D + kb * 32; }
    }
};
__device__ __forceinline__ void ph_wconv_small(const Frame& F, const Params& p) {
    LAS float* scr = (LAS float*)(F.lds + F.wave * 8704);
    const int gw = F.vcu * 8 + F.wave, NGW = F.G * 8;
    { DecSmall dec{&p, F.ws}; wc_loop(F, dec, 0, DecSmall::NIT, gw, NGW); }
    bf16_t* wsb = WSP(bf16_t, WS_WSB);
    for (int i = (F.vcu * 512 + F.tid) * 4; i < 2 * 8 * 128 * 128; i += F.G * 512 * 4) { const f32x4 v = *(const f32x4*)(p.a_w_s + i); u32x2 w; w.x = cvt_pk_bf16(v[0], v[1]); w.y = cvt_pk_bf16(v[2], v[3]); *(u32x2*)(wsb + i) = w; }
}
constexpr int CW_WCQ = 16384;
__device__ __forceinline__ bf16_t* resid_row(const Frame& F, const Params& p, int r, bool alt) { return r < ROWS_L ? (alt ? WSP(bf16_t, WS_XALT) : (bf16_t*)p.out) + (size_t)r * D : WSP(bf16_t, WS_XC) + (size_t)(r - ROWS_L) * D; }
__device__ __forceinline__ f32x4 bf4_to_f32(const u32x2 w) { return (f32x4){bf_lo(w.x), bf_hi(w.x), bf_lo(w.y), bf_hi(w.y)}; }
__device__ __forceinline__ int mod_row(int r) { return r < ROWS_L ? (r >> 12) : 8; }

__device__ __forceinline__ void moe_combine(const Frame& F, f32x4 (&v)[4], int myslot, const f32x4 (&g2)[4]) {
    const bf16_t* YE = WSP(bf16_t, WS_YE); const float* GATE = WSP(float, WS_GATE);
    f32x4 s[4];
#pragma unroll
    for (int j = 0; j < 4; ++j) s[j] = (f32x4){0.f, 0.f, 0.f, 0.f};
    unsigned long long m = __ballot(myslot >= 0) & 0xffffull;
    while (m) {
        const int e0 = __builtin_ctzll(m); m &= m - 1; const bool two = m != 0ull; const int e1 = two ? __builtin_ctzll(m) : e0; if (two) m &= m - 1;
        const int s0 = __shfl(myslot, e0), s1 = __shfl(myslot, e1);
        const bf16_t* y0 = YE + ((size_t)e0 * EROWS + s0) * D + 4 * F.lane; const bf16_t* y1 = YE + ((size_t)e1 * EROWS + s1) * D + 4 * F.lane;
        const float g0 = GATE[(size_t)e0 * EROWS + s0], g1 = two ? GATE[(size_t)e1 * EROWS + s1] : 0.f;
        u32x2 w0[4], w1[4];
#pragma unroll
        for (int j = 0; j < 4; ++j) { w0[j] = *(const u32x2*)(y0 + 256 * j); w1[j] = *(const u32x2*)(y1 + 256 * j); }
#pragma unroll
        for (int j = 0; j < 4; ++j) { s[j] += (f32x4){bf_lo(w0[j].x), bf_hi(w0[j].x), bf_lo(w0[j].y), bf_hi(w0[j].y)} * g0;
            s[j] += (f32x4){bf_lo(w1[j].x), bf_hi(w1[j].x), bf_lo(w1[j].y), bf_hi(w1[j].y)} * g1; }
    }
#pragma unroll
    for (int j = 0; j < 4; ++j) v[j] += g2[j] * s[j];
}
__device__ __forceinline__ int lat_row(int gw, int NGW, int k) { return (gw & 7) * SEQ + (gw >> 3) + k * (NGW >> 3); }
__device__ __forceinline__ int lat_cnt(int gw, int NGW) { const int s8 = NGW >> 3; return (SEQ - (gw >> 3) + s8 - 1) / s8; }
__device__ __forceinline__ void load_vec4(f32x4 (&o)[4], const float* base, int lane) {
#pragma unroll
    for (int j = 0; j < 4; ++j) o[j] = *(const f32x4*)(base + 4 * lane + 256 * j); }
__device__ __forceinline__ void ph_t1(const Frame& F, const Params& p, int L, int nrows) {
    const int gw = F.vcu * 8 + F.wave, NGW = F.G * 8;
    const float* MOD = WSP(float, WS_MOD); bf16_t* HA = WSP(bf16_t, WS_HA); const int* slotmap = WSP(int, WS_SLOT);
    const int cntL = lat_cnt(gw, NGW), cntC = (nrows > ROWS_L && gw < nrows - ROWS_L) ? (nrows - ROWS_L - gw + NGW - 1) / NGW : 0, cnt = cntL + cntC;
#define T1_ROW(k_) ((k_) < cntL ? lat_row(gw, NGW, (k_)) : ROWS_L + gw + ((k_) - cntL) * NGW)
    f32x4 A[4], B[4], G2[4];
    { f32x4 g[4], sc[4]; const float* mp = MOD + ((size_t)L * 9 + (gw & 7)) * NMOD; load_vec4(g, p.norm_mix_g + (size_t)L * D, F.lane); load_vec4(B, mp, F.lane); load_vec4(sc, mp + D, F.lane);
#pragma unroll
      for (int j = 0; j < 4; ++j) A[j] = g[j] * (sc[j] + 1.0f);
      if (L != 0) load_vec4(G2, MOD + ((size_t)(L - 1) * 9 + (gw & 7)) * NMOD + 5 * D, F.lane);
      else {
#pragma unroll
          for (int j = 0; j < 4; ++j) G2[j] = (f32x4){0.f, 0.f, 0.f, 0.f}; } }
    f32x4 vn[4]; u32x2 wn[4]; int sn = -1;
#define T1_LOAD(rr) do { if (L == 0) { const float* xr_ = ((rr) < ROWS_L ? p.x + (size_t)(rr) * D : p.ctx + (size_t)((rr) - ROWS_L) * D) + 4 * F.lane; \
            _Pragma("unroll") for (int j = 0; j < 4; ++j) vn[j] = *(const f32x4*)(xr_ + 256 * j); } \
        else { const bf16_t* xr_ = resid_row(F, p, (rr), false) + 4 * F.lane; _Pragma("unroll") for (int j = 0; j < 4; ++j) wn[j] = *(const u32x2*)(xr_ + 256 * j); } \
        sn = -1; if (L != 0 && F.lane < 16) sn = slotmap[(size_t)(rr) * 16 + F.lane]; } while (0)
#pragma unroll
    for (int j = 0; j < 4; ++j) { vn[j] = (f32x4){0.f, 0.f, 0.f, 0.f}; wn[j] = (u32x2){0u, 0u}; }
    if (cnt > 0) T1_LOAD(T1_ROW(0));
    for (int k = 0; k < cnt; ++k) { const int r = T1_ROW(k);
        f32x4 v[4]; const int myslot = sn;
#pragma unroll
        for (int j = 0; j < 4; ++j) v[j] = (L == 0) ? vn[j] : bf4_to_f32(wn[j]);
        if (k + 1 < cnt) T1_LOAD(T1_ROW(k + 1));
        const bool isc = r >= ROWS_L;
        if (L != 0) {
            if (!isc) moe_combine(F, v, myslot, G2);
            else { f32x4 g2c[4]; load_vec4(g2c, MOD + ((size_t)(L - 1) * 9 + 8) * NMOD + 5 * D, F.lane); moe_combine(F, v, myslot, g2c); }
            bf16_t* xr = resid_row(F, p, r, false) + 4 * F.lane;
#pragma unroll
            for (int j = 0; j < 4; ++j) gm::st_bf4(xr + 256 * j, v[j]); }
        float ss = 0.f;
#pragma unroll
        for (int j = 0; j < 4; ++j) ss += (v[j][0] * v[j][0] + v[j][1] * v[j][1]) + (v[j][2] * v[j][2] + v[j][3] * v[j][3]);
        const float rs = 1.0f / sqrtf(wave_sum(ss) * (1.0f / D) + EPS);
        bf16_t* hr = HA + (size_t)r * D + 4 * F.lane;
        if (!isc) {
#pragma unroll
            for (int j = 0; j < 4; ++j) gm::st_bf4(hr + 256 * j, (v[j] * rs) * A[j] + B[j]); }
        else { const float* mp = MOD + ((size_t)L * 9 + 8) * NMOD + 4 * F.lane; const float* gp = p.norm_mix_g + (size_t)L * D + 4 * F.lane;
#pragma unroll
            for (int j = 0; j < 4; ++j) { const f32x4 g = *(const f32x4*)(gp + 256 * j), sh = *(const f32x4*)(mp + 256 * j), sc = *(const f32x4*)(mp + D + 256 * j);
                gm::st_bf4(hr + 256 * j, (v[j] * rs * g) * (sc + 1.0f) + sh); } }
    }
#undef T1_LOAD
#undef T1_ROW
}
__device__ __forceinline__ void ph_spatial(const Frame& F, const Params& p, int j, int nchunks) {
    const bf16_t* V = WSP(bf16_t, WS_V); const bf16_t* U = WSP(bf16_t, WS_U); bf16_t* P = WSP(bf16_t, WS_HA); const float* LNP = WSP(float, WS_VT2);
    LAS bf16_t* As = (LAS bf16_t*)F.lds; LAS bf16_t* Bs = (LAS bf16_t*)(F.lds + 128 * 272);
    const int g = F.vcu & 7;
    const int w4 = F.wave >> 1, w2 = F.wave & 1, fr = F.lane & 15, fq = F.lane >> 4;
    const int tok = F.tid >> 2, cs = F.tid & 3;
    { const bf16_t* a = WSP(bf16_t, WS_WSB) + (((size_t)j * 8 + g) * 128 + tok) * 128 + cs * 32;
#pragma unroll
      for (int q4 = 0; q4 < 4; ++q4) *(LAS u32x4*)(As + tok * 136 + cs * 32 + q4 * 8) = *(const u32x4*)(a + q4 * 8); }
    float lgv[32], lbv[32];
    { const float* lgp = p.a_ln_g + (size_t)j * D + g * 128 + cs * 32; const float* lbp = p.a_ln_b + (size_t)j * D + g * 128 + cs * 32;
#pragma unroll
      for (int q = 0; q < 8; ++q) { const f32x4 a = *(const f32x4*)(lgp + 4 * q), b = *(const f32x4*)(lbp + 4 * q);
#pragma unroll
          for (int k = 0; k < 4; ++k) { lgv[4 * q + k] = a[k]; lbv[4 * q + k] = b[k]; } } }
    float bsv[2];
#pragma unroll
    for (int mi = 0; mi < 2; ++mi) bsv[mi] = p.a_b_s[((size_t)j * 8 + g) * 128 + 32 * w4 + 16 * mi + fr];
    u32x4 vq[4]; f32x4 lp[2];
#define G2_LOAD(tt) do { const int ch_ = (tt) >> 3; const bf16_t* vr_ = V + ((size_t)ch_ * 128 + tok) * D + g * 128 + cs * 32; \
        _Pragma("unroll") for (int q4 = 0; q4 < 4; ++q4) vq[q4] = *(const u32x4*)(vr_ + q4 * 8); \
        const f32x4* pp_ = (const f32x4*)(LNP + ((size_t)ch_ * 128 + tok) * 32) + 2 * cs; lp[0] = pp_[0]; lp[1] = pp_[1]; } while (0)
    const int ntask = nchunks * 8;
    if (F.vcu < ntask) G2_LOAD(F.vcu);
    for (int t = F.vcu; t < ntask; t += F.G) {
        const int ch = t >> 3;
        float sm = (lp[0][0] + lp[0][2]) + (lp[1][0] + lp[1][2]), sq = (lp[0][1] + lp[0][3]) + (lp[1][1] + lp[1][3]);
        sm += __shfl_xor(sm, 1); sq += __shfl_xor(sq, 1); sm += __shfl_xor(sm, 2); sq += __shfl_xor(sq, 2);
        const float mean = sm * (1.0f / D), rstd = 1.0f / sqrtf(sq * (1.0f / D) - mean * mean + EPS);
#pragma unroll
        for (int q4 = 0; q4 < 4; ++q4)
#pragma unroll
            for (int k = 0; k < 4; ++k) { const int cl = q4 * 8 + k * 2;
                Bs[(cs * 32 + cl) * 136 + tok] = f2bf((bf_lo(vq[q4][k]) - mean) * rstd * lgv[cl] + lbv[cl]); Bs[(cs * 32 + cl + 1) * 136 + tok] = f2bf((bf_hi(vq[q4][k]) - mean) * rstd * lgv[cl + 1] + lbv[cl + 1]); }
        u32x2 uu[2][4];
#pragma unroll
        for (int mi = 0; mi < 2; ++mi) { const size_t ro = ((size_t)ch * 128 + 32 * w4 + 16 * mi + fr) * D + g * 128;
#pragma unroll
            for (int ni = 0; ni < 4; ++ni) uu[mi][ni] = *(const u32x2*)(U + ro + 64 * w2 + 16 * ni + 4 * fq); }
        __syncthreads();
        if (t + F.G < ntask) G2_LOAD(t + F.G);
        f32x4 acc[2][4];
#pragma unroll
        for (int mi = 0; mi < 2; ++mi)
#pragma unroll
            for (int ni = 0; ni < 4; ++ni) acc[mi][ni] = (f32x4){0.f, 0.f, 0.f, 0.f};
#pragma unroll
        for (int ks = 0; ks < 4; ++ks) { bf16x8 af[2], bfr[4];
#pragma unroll
            for (int mi = 0; mi < 2; ++mi) af[mi] = *(const LAS bf16x8*)(As + (32 * w4 + 16 * mi + fr) * 136 + ks * 32 + fq * 8);
#pragma unroll
            for (int ni = 0; ni < 4; ++ni) bfr[ni] = *(const LAS bf16x8*)(Bs + (64 * w2 + 16 * ni + fr) * 136 + ks * 32 + fq * 8);
#pragma unroll
            for (int mi = 0; mi < 2; ++mi)
#pragma unroll
                for (int ni = 0; ni < 4; ++ni) acc[mi][ni] = __builtin_amdgcn_mfma_f32_16x16x32_bf16(bfr[ni], af[mi], acc[mi][ni], 0, 0, 0); }
#pragma unroll
        for (int mi = 0; mi < 2; ++mi) { const size_t ro = ((size_t)ch * 128 + 32 * w4 + 16 * mi + fr) * D + g * 128;
#pragma unroll
            for (int ni = 0; ni < 4; ++ni) { const int d0 = 64 * w2 + 16 * ni + 4 * fq; const u32x2 u2 = uu[mi][ni]; const f32x4 sv = acc[mi][ni] + bsv[mi];
                gm::st_bf4(P + ro + d0, (f32x4){bf_lo(u2.x) * sv[0], bf_hi(u2.x) * sv[1], bf_lo(u2.y) * sv[2], bf_hi(u2.y) * sv[3]}); } }
        __syncthreads();
    }
#undef G2_LOAD
}
__device__ __forceinline__ void ph_prefix(const Frame& F, const Params& p, int j) {
    const bf16_t* UT = WSP(bf16_t, WS_UT); bf16_t* ST = WSP(bf16_t, WS_ST); const float* logg = WSP(float, WS_LOGG) + j * 8;
#define UT_LD(o_) ({ const u32x2 w_ = *(const u32x2*)(UT + (o_)); (f32x4){bf_lo(w_.x), bf_hi(w_.x), bf_lo(w_.y), bf_hi(w_.y)}; })
    const int nq = 32 * 2 * (int)(PBLK / 4);
    for (int q = F.vcu * 512 + F.tid; q < nq; q += F.G * 512) {
        const int e4 = q & (int)(PBLK / 4 - 1), dir = (q >> 14) & 1, bh = q >> 15;
        const float dec = fexp2(logg[dir * 4 + (bh & 3)] * (float)SCH);
        f32x4 S = UT_LD((size_t)((bh * 9 + 8) * 2 + dir) * PBLK + e4 * 4);
        gm::st_bf4(ST + (size_t)((bh * 9 + 8) * 2 + dir) * PBLK + e4 * 4, (f32x4){0.f, 0.f, 0.f, 0.f});
        for (int s = 0; s < NX; ++s) { const int X = dir ? (NX - 1 - s) : s; const size_t o = (size_t)((bh * 9 + X) * 2 + dir) * PBLK + e4 * 4;
            gm::st_bf4(ST + o, S); S = S * dec + UT_LD(o); }
    }
#undef UT_LD
}
__device__ __forceinline__ float half_sum(float v) {
#pragma unroll
    for (int o = 1; o < 32; o <<= 1) v += __shfl_xor(v, o);
    return v;
}
__device__ __forceinline__ void ph_headnorm(const Frame& F, int nrows) {
    const int gw = F.vcu * 8 + F.wave, NGW = F.G * 8;
    const bf16_t* OF = WSP(bf16_t, WS_OF); const bf16_t* OB = WSP(bf16_t, WS_OB); const bf16_t* GF = WSP(bf16_t, WS_GF); const bf16_t* GB = WSP(bf16_t, WS_GB); bf16_t* YR = WSP(bf16_t, WS_HA);
    u32x4 wn[2][2], gqn[2][2];
#define HN_LOAD(rr) do { const size_t o_ = (size_t)(rr) * D + 8 * F.lane; _Pragma("unroll") for (int k = 0; k < 2; ++k) _Pragma("unroll") for (int dir = 0; dir < 2; ++dir) { \
        wn[k][dir] = *(const u32x4*)((dir ? OB : OF) + o_ + 512 * k); gqn[k][dir] = *(const u32x4*)((dir ? GB : GF) + o_ + 512 * k); } } while (0)
    if (gw < nrows) HN_LOAD(gw);
    for (int r = gw; r < nrows; r += NGW) { const size_t o = (size_t)r * D + 8 * F.lane;
        u32x4 wc_[2][2], gc_[2][2];
#pragma unroll
        for (int k = 0; k < 2; ++k)
#pragma unroll
            for (int dir = 0; dir < 2; ++dir) { wc_[k][dir] = wn[k][dir]; gc_[k][dir] = gqn[k][dir]; }
        if (r + NGW < nrows) HN_LOAD(r + NGW);
#pragma unroll
        for (int k = 0; k < 2; ++k) { float y[8];
#pragma unroll
            for (int q = 0; q < 8; ++q) y[q] = 0.f;
#pragma unroll
            for (int dir = 0; dir < 2; ++dir) { const u32x4 w = wc_[k][dir], gq = gc_[k][dir];
                float v[8], g[8];
#pragma unroll
                for (int q = 0; q < 4; ++q) { v[2 * q] = bf_lo(w[q]); v[2 * q + 1] = bf_hi(w[q]); g[2 * q] = bf_lo(gq[q]); g[2 * q + 1] = bf_hi(gq[q]); }
                const float mean = half_sum(((v[0] + v[1]) + (v[2] + v[3])) + ((v[4] + v[5]) + (v[6] + v[7]))) * (1.0f / DH); float sq = 0.f;
#pragma unroll
                for (int q = 0; q < 8; ++q) { v[q] -= mean; sq += v[q] * v[q]; }
                const float rstd = 1.0f / sqrtf(half_sum(sq) * (1.0f / DH) + EPS);
#pragma unroll
                for (int q = 0; q < 8; ++q) y[q] += g[q] * v[q] * rstd; }
            u32x4 ow; ow.x = cvt_pk_bf16(y[0], y[1]); ow.y = cvt_pk_bf16(y[2], y[3]); ow.z = cvt_pk_bf16(y[4], y[5]); ow.w = cvt_pk_bf16(y[6], y[7]);
            *(u32x4*)(YR + o + 512 * k) = ow; } }
#undef HN_LOAD
}
__device__ __forceinline__ void rt_fill(const Frame& F, const Params& p, int L) {
    LAS float* wt = (LAS float*)F.lds;
    for (int i = F.tid * 4; i < D * NEXP; i += 512 * 4) { const f32x4 w = *(const f32x4*)(p.moe_w_router + (size_t)L * D * NEXP + i); const int k = i >> 4, e0 = i & 15;
        wt[(e0 + 0) * D + k] = w[0]; wt[(e0 + 1) * D + k] = w[1]; wt[(e0 + 2) * D + k] = w[2]; wt[(e0 + 3) * D + k] = w[3]; }
    __syncthreads();
}
template <int NR>
__device__ __forceinline__ void rt_rows(const Frame& F, const Params& p, int L, int fw, int nfw, int k0, int k1, bool with_ctx) {
    LAS float* wt = (LAS float*)F.lds;
    const float* MOD = WSP(float, WS_MOD); bf16_t* HA = WSP(bf16_t, WS_HA); float* AFF = WSP(float, WS_AFF);
    const int fwr = nfw - 1 - fw;
    const int cntL = lat_cnt(fw, nfw), cntC = (with_ctx && fwr < ROWS_C) ? (ROWS_C - fwr + nfw - 1) / nfw : 0;
    if (k1 > cntL + cntC) k1 = cntL + cntC;
#define RT_ROW(k_) ((k_) < cntL ? lat_row(fw, nfw, (k_)) : ROWS_L + fwr + ((k_) - cntL) * nfw)
    f32x4 A[4], B[4];
    { f32x4 g[4], sc[4]; const float* mp = MOD + ((size_t)L * 9 + (fw & 7)) * NMOD + 3 * D; load_vec4(g, p.norm_ffn_g + (size_t)L * D, F.lane); load_vec4(B, mp, F.lane); load_vec4(sc, mp + D, F.lane);
#pragma unroll
      for (int j = 0; j < 4; ++j) A[j] = g[j] * (sc[j] + 1.0f); }
    u32x2 vn[NR][4]; const bool alt = (L == DEPTH - 1);
#define RT_LOAD(kz) do { _Pragma("unroll") for (int q = 0; q < NR; ++q) { const int kq_ = (kz) + q; const bf16_t* xq_ = resid_row(F, p, RT_ROW(kq_ < k1 ? kq_ : (kz)), alt) + 4 * F.lane; \
        _Pragma("unroll") for (int j = 0; j < 4; ++j) vn[q][j] = *(const u32x2*)(xq_ + 256 * j); } } while (0)
    if (k0 < k1) RT_LOAD(k0);
    for (int kk = k0; kk < k1; kk += NR) {
        int rr[NR]; bool ok[NR];
#pragma unroll
        for (int q = 0; q < NR; ++q) { ok[q] = kk + q < k1; rr[q] = RT_ROW(ok[q] ? kk + q : kk); }
        f32x4 v[NR][4]; float lg[NR][16];
#pragma unroll
        for (int q = 0; q < NR; ++q)
#pragma unroll
            for (int j = 0; j < 4; ++j) v[q][j] = bf4_to_f32(vn[q][j]);
        if (kk + NR < k1) RT_LOAD(kk + NR);
#pragma unroll
        for (int q = 0; q < NR; ++q) { float ss = 0.f;
#pragma unroll
            for (int j = 0; j < 4; ++j) ss += (v[q][j][0] * v[q][j][0] + v[q][j][1] * v[q][j][1]) + (v[q][j][2] * v[q][j][2] + v[q][j][3] * v[q][j][3]);
            const float rs = 1.0f / sqrtf(wave_sum(ss) * (1.0f / D) + EPS);
            bf16_t* hr = HA + (size_t)rr[q] * D + 4 * F.lane;
            if (rr[q] < ROWS_L) {
#pragma unroll
                for (int j = 0; j < 4; ++j) { v[q][j] = (v[q][j] * rs) * A[j] + B[j]; if (ok[q]) gm::st_bf4(hr + 256 * j, v[q][j]); } }
            else { const float* mp = MOD + ((size_t)L * 9 + 8) * NMOD + 3 * D + 4 * F.lane; const float* gp = p.norm_ffn_g + (size_t)L * D + 4 * F.lane;
#pragma unroll
                for (int j = 0; j < 4; ++j) { const f32x4 g = *(const f32x4*)(gp + 256 * j), sh = *(const f32x4*)(mp + 256 * j), sc = *(const f32x4*)(mp + D + 256 * j);
                    v[q][j] = (v[q][j] * rs * g) * (sc + 1.0f) + sh; if (ok[q]) gm::st_bf4(hr + 256 * j, v[q][j]); } } }
#pragma unroll
        for (int e = 0; e < 16; ++e) { f32x2 a[NR];
            f32x4 w4[4];
#pragma unroll
            for (int j = 0; j < 4; ++j) w4[j] = *(const LAS f32x4*)(wt + e * D + 4 * F.lane + 256 * j);
            __builtin_amdgcn_sched_barrier(0);
#pragma unroll
            for (int q = 0; q < NR; ++q) a[q] = (f32x2){0.f, 0.f};
#pragma unroll
            for (int j = 0; j < 4; ++j) { const f32x4 w = w4[j]; const f32x2 wl = (f32x2){w[0], w[1]}, wh = (f32x2){w[2], w[3]};
#pragma unroll
                for (int q = 0; q < NR; ++q) { a[q] += (f32x2){v[q][j][0], v[q][j][1]} * wl; a[q] += (f32x2){v[q][j][2], v[q][j][3]} * wh; } }
#pragma unroll
            for (int q = 0; q < NR; ++q) lg[q][e] = a[q].x + a[q].y;
            __builtin_amdgcn_sched_barrier(0); }
        float lgt[NR];
#pragma unroll
        for (int q = 0; q < NR; ++q) { LAS float* red = (LAS float*)(F.lds + 65536 + F.wave * 8192 + (q & 1) * 4096);
#pragma unroll
            for (int e = 0; e < 16; ++e) red[e * 64 + F.lane] = lg[q][e];
            asm volatile("" ::: "memory");
            const LAS f32x4* rp = (const LAS f32x4*)(red + (F.lane >> 2) * 64 + (F.lane & 3) * 16);
            const f32x4 r0 = rp[0], r1 = rp[1], r2 = rp[2], r3 = rp[3];
            asm volatile("" ::: "memory");
            float t = ((r0[0] + r0[1]) + (r0[2] + r0[3])) + ((r1[0] + r1[1]) + (r1[2] + r1[3])) + (((r2[0] + r2[1]) + (r2[2] + r2[3])) + ((r3[0] + r3[1]) + (r3[2] + r3[3])));
            t += __shfl_xor(t, 2); t += __shfl_xor(t, 1); lgt[q] = t; }
#pragma unroll
        for (int q = 0; q < NR; ++q) { float mx = lgt[q];
#pragma unroll
            for (int o = 4; o < 64; o <<= 1) mx = fmaxf(mx, __shfl_xor(mx, o));
            const float pe = __expf(lgt[q] - mx); float den = pe;
#pragma unroll
            for (int o = 4; o < 64; o <<= 1) den += __shfl_xor(den, o);
            if ((F.lane & 3) == 0 && ok[q]) { const float a = pe / den; const int e = F.lane >> 2, r = rr[q];
                if (r < ROWS_L) AFF[((size_t)(r >> 12) * 16 + e) * SEQ + (r & (SEQ - 1))] = a;
                else { const int rc = r - ROWS_L; AFF[(size_t)128 * SEQ + ((size_t)(rc >> 8) * 16 + e) * CTXL + (rc & (CTXL - 1))] = a; } } }
    }
#undef RT_LOAD
#undef RT_ROW
}
__device__ __forceinline__ void ph_topk(const Frame& F, int ntasks) {
    LAS unsigned* keys = (LAS unsigned*)F.lds;
    LAS unsigned* hist = (LAS unsigned*)(F.lds + 16384);
    LAS unsigned* misc = (LAS unsigned*)(F.lds + 16384 + 1024);
    const float* AFF = WSP(float, WS_AFF); int* IDX = WSP(int, WS_IDX); float* GATE = WSP(float, WS_GATE); int* SLOT = WSP(int, WS_SLOT);
    for (int task = F.vcu; task < ntasks; task += F.G) {
        const bool lat = task < 128; const int be = lat ? task : task - 128, b = be >> 4, e = be & 15;
        const int n = lat ? SEQ : CTXL, cap = lat ? CAP_L : CAP_C;
        const float* src = AFF + (lat ? (size_t)be * SEQ : (size_t)128 * SEQ + (size_t)be * CTXL);
        for (int i = F.tid; i < n; i += 512) keys[i] = __builtin_bit_cast(unsigned, src[i]);
        if (F.tid == 0) { misc[0] = 0u; misc[1] = (unsigned)cap; }
        __syncthreads();
        unsigned mask = 0u;
        for (int pass = 0; pass < 4; ++pass) { const int shift = 24 - 8 * pass;
            if (F.tid < 256) hist[F.tid] = 0u;
            __syncthreads();
            const unsigned prefix = misc[0];
            for (int i = F.tid; i < n; i += 512) { const unsigned k = keys[i]; if ((k & mask) == prefix) __hip_atomic_fetch_add(&hist[(k >> shift) & 255u], 1u, __ATOMIC_RELAXED, __HIP_MEMORY_SCOPE_WORKGROUP); }
            __syncthreads();
            if (F.wave == 0) {
                const unsigned need = misc[1]; const u32x4 hc = *(const LAS u32x4*)(hist + 4 * F.lane); const unsigned sl = (hc[0] + hc[1]) + (hc[2] + hc[3]);
                unsigned suf = sl;
#pragma unroll
                for (int o = 1; o < 64; o <<= 1) { const unsigned t = __shfl_down(suf, o); if (F.lane + o < 64) suf += t; }
                const unsigned above = suf - sl;
                if (above < need && need <= above + sl) {
                    const unsigned c3 = above, c2 = c3 + hc[3], c1 = c2 + hc[2], c0 = c1 + hc[1];
                    const int d = (c3 + hc[3] >= need) ? 3 : (c2 + hc[2] >= need) ? 2 : (c1 + hc[1] >= need) ? 1 : 0;
                    const unsigned cum = d == 3 ? c3 : d == 2 ? c2 : d == 1 ? c1 : c0;
                    misc[0] = prefix | ((unsigned)(4 * F.lane + d) << shift); misc[1] = need - cum; } }
            mask |= 255u << shift;
            __syncthreads();
        }
        const unsigned T = misc[0], need_eq = misc[1];
        const int i0 = F.tid * 8; unsigned cg = 0u, ce = 0u; unsigned kk[8];
#pragma unroll
        for (int q = 0; q < 8; ++q) { const int i = i0 + q; kk[q] = (i < n) ? keys[i] : 0u; cg += (i < n && kk[q] > T) ? 1u : 0u; ce += (i < n && kk[q] == T) ? 1u : 0u; }
        unsigned pk = cg | (ce << 16), incl = pk;
#pragma unroll
        for (int o = 1; o < 64; o <<= 1) { const unsigned t = __shfl_up(incl, o); if (F.lane >= o) incl += t; }
        if (F.lane == 63) misc[8 + F.wave] = incl;
        __syncthreads();
        unsigned wbase = 0u;
#pragma unroll
        for (int w = 0; w < 8; ++w) wbase += (w < F.wave) ? misc[8 + w] : 0u;
        const unsigned excl = wbase + incl - pk; unsigned ng = excl & 0xffffu, ne = excl >> 16;
        const int slotbase = lat ? b * CAP_L : NB * CAP_L + b * CAP_C; const int rowbase = lat ? b * SEQ : ROWS_L + b * CTXL;
#pragma unroll
        for (int q = 0; q < 8; ++q) { const int i = i0 + q; if (i < n) {
                const bool gt = kk[q] > T, eq = kk[q] == T; const bool sel = gt || (eq && ne < need_eq);
                const int slot = slotbase + (int)(ng + (ne < need_eq ? ne : need_eq));
                if (sel) { IDX[e * EROWS + slot] = rowbase + i; GATE[e * EROWS + slot] = __builtin_bit_cast(float, kk[q]); }
                SLOT[(size_t)(rowbase + i) * 16 + e] = sel ? slot : -1;
                ng += gt ? 1u : 0u; ne += eq ? 1u : 0u; } }
        __syncthreads();
    }
}
__device__ __forceinline__ void ph_final(const Frame& F, const Params& p) {
    const int gw = F.vcu * 8 + F.wave, NGW = F.G * 8; const int* slotmap = WSP(int, WS_SLOT);
    const int cnt = lat_cnt(gw, NGW);
    f32x4 G2[4], FG[4];
    load_vec4(G2, WSP(float, WS_MOD) + ((size_t)(DEPTH - 1) * 9 + (gw & 7)) * NMOD + 5 * D, F.lane); load_vec4(FG, p.final_norm_g, F.lane);
    u32x2 vn[4]; int sn = -1;
#define FN_LOAD(rr) do { const bf16_t* xr_ = resid_row(F, p, (rr), true) + 4 * F.lane; \
        _Pragma("unroll") for (int j = 0; j < 4; ++j) vn[j] = *(const u32x2*)(xr_ + 256 * j); \
        sn = -1; if (F.lane < 16) sn = slotmap[(size_t)(rr) * 16 + F.lane]; } while (0)
    if (cnt > 0) FN_LOAD(lat_row(gw, NGW, 0));
    for (int k = 0; k < cnt; ++k) { const int r = lat_row(gw, NGW, k); float* xr = p.out + (size_t)r * D + 4 * F.lane; f32x4 v[4]; const int myslot = sn;
#pragma unroll
        for (int j = 0; j < 4; ++j) v[j] = bf4_to_f32(vn[j]);
        if (k + 1 < cnt) FN_LOAD(lat_row(gw, NGW, k + 1));
        moe_combine(F, v, myslot, G2);
        float ss = 0.f;
#pragma unroll
        for (int j = 0; j < 4; ++j) ss += (v[j][0] * v[j][0] + v[j][1] * v[j][1]) + (v[j][2] * v[j][2] + v[j][3] * v[j][3]);
        const float rs = 1.0f / sqrtf(wave_sum(ss) * (1.0f / D) + EPS);
#pragma unroll
        for (int j = 0; j < 4; ++j) *(f32x4*)(xr + 256 * j) = v[j] * rs * FG[j]; }
#undef FN_LOAD
}

constexpr int CW_HND = 8192;
__device__ __forceinline__ void handoff_publish(const Frame& F, unsigned* ctr) {
    asm volatile("s_waitcnt vmcnt(0)" ::: "memory"); __syncthreads();
    if (F.tid == 0) { __builtin_amdgcn_fence(__ATOMIC_RELEASE, "agent"); asm volatile("s_waitcnt vmcnt(0)" ::: "memory"); (void)__hip_atomic_fetch_add(ctr, 1u, __ATOMIC_RELAXED, __HIP_MEMORY_SCOPE_AGENT); }
}
__device__ __forceinline__ void handoff_publish_wt(const Frame& F, unsigned* ctr) {
    asm volatile("s_waitcnt vmcnt(0)" ::: "memory"); __syncthreads();
    if (F.tid == 0) (void)__hip_atomic_fetch_add(ctr, 1u, __ATOMIC_RELAXED, __HIP_MEMORY_SCOPE_AGENT);
}
__device__ __forceinline__ void handoff_wait(const Frame& F, unsigned* ctr, unsigned need) {
    if (F.tid == 0) { unsigned sp = 0;
        while (__hip_atomic_load(ctr, __ATOMIC_RELAXED, __HIP_MEMORY_SCOPE_AGENT) < need) { __builtin_amdgcn_s_sleep(2); if (++sp > (1u << 20)) break; }
        __builtin_amdgcn_fence(__ATOMIC_ACQUIRE, "agent"); asm volatile("s_waitcnt vmcnt(0)" ::: "memory"); }
    __syncthreads();
}
constexpr int PH_PER_LAYER = 16, PH_FINAL = 1 + PH_PER_LAYER * DEPTH, PH_TOTAL = PH_FINAL + 1;

#ifdef PROBE_SITE
#ifndef PROBE_K
#define PROBE_K 8
#endif
#define PB(s) unsigned long long pt0_ = 0ull; if ((s) == PROBE_SITE) pt0_ = __builtin_amdgcn_s_memrealtime()
#define PE(s) if ((s) == PROBE_SITE) probe_acc += __builtin_amdgcn_s_memrealtime() - pt0_
#else
#define PB(s) do {} while (0)
#define PE(s) do {} while (0)
#endif
template <int ONLY> __global__ void __launch_bounds__(512, 2) mk_fwd(Params p) {
    extern __shared__ __attribute__((aligned(16))) unsigned char lds_raw[];
    Frame F0; frame_init(F0, (LAS unsigned char*)lds_raw);
    volatile LAS unsigned* MISC = (volatile LAS unsigned*)(F0.lds + MISC_OFF);
    if (F0.tid < 32) MISC[F0.tid] = 0u;
    __syncthreads();
#if MK_SINGLE
    XcdBarrier bar = xcd_barrier_post((unsigned*)(p.ws + WS_CTL) + CW_BAR, MISC + 8);
#define SEAM() do { XcdBarrier b_ = bar; asm volatile("" : "+s"(b_.bar)); xcd_barrier(b_); } while (0)
#else
#define SEAM() do {} while (0)
#endif
#ifdef PROBE_SITE
    unsigned long long probe_acc = 0ull;
#endif
    const int lo = p.ph_lo, hi = p.ph_hi;
#define IN(k) (lo <= (k) && (k) < hi)
#ifdef ONLY_SITE
#define SITE(s) ((s) == ONLY_SITE && (ONLY < 0 || (s) == ONLY))
#else
#define SITE(s) (ONLY < 0 || (s) == ONLY)
#endif
#define SITE_ENTER() KParams pp_ = (KParams)__builtin_amdgcn_kernarg_segment_ptr(); asm volatile("" : "+s"(pp_)); Params P; load_params(P, pp_); Frame F; frame_init(F, (LAS unsigned char*)lds_raw); F.ws = P.ws; const int c = F.bx; (void)c

    if (SITE(0) && IN(0)) { SITE_ENTER(); PB(0); ph_mod(F, P); ph_tables(F, P); ph_wconv_small(F, P); SEAM(); PE(0); }

#pragma unroll 1
    for (int L = 0; L < DEPTH; ++L) {
        const int base = 1 + PH_PER_LAYER * L, j = L >> 1; const bool last = (L == DEPTH - 1), kind1 = (L & 1) != 0;
        if (SITE(1) && IN(base + 0)) { SITE_ENTER(); PB(1);
            if (L == 0) { ph_wconv_moe(F, P, L, 0, WC_EARLY, F.vcu * 8 + F.wave, F.G * 8); ph_wconv_moe(F, P, L, WC_NGU, WC_NALL, F.vcu * 8 + F.wave, F.G * 8); }
            else if (!(kind1 && !last)) { if (kind1) ph_wconv_moe(F, P, L, WC_EARLY, WC_NGU, F.vcu * 8 + F.wave, F.G * 8);
                   ph_wconv_moe(F, P, L, WC_NGU + WD_EARLY, WC_NALL, F.vcu * 8 + F.wave, F.G * 8); }
            ph_t1(F, P, L, ROWS); SEAM(); PE(1); }
        if (!kind1) {
            if (SITE(2) && IN(base + 1)) {
                SITE_ENTER(); PB(2);
                gm::SchedG S{nullptr, (const char*)WSP(bf16_t, WS_HA), (const char*)(WSP(bf16_t, WS_WAIN) + (size_t)j * 2048 * D), 2048u, 2048u, 16, ROWS / 256, 8, 0, 0, 0, 0, ROWS / 256, ROWS / 256, 0, F.G, c};
                gm::EpiGelu E{WSP(bf16_t, WS_U), WSP(bf16_t, WS_V), WSP(float, WS_VT2)};
                gm::gemm_units(F.lds, F.tid, S, E);
                { const int rem = ((ROWS / 256) * 8) % F.G;
                  if (rem > 0 && c >= rem) { __syncthreads(); ph_wconv_moe(F, P, L, WC_EARLY, WC_NGU, (c - rem) * 8 + F.wave, (F.G - rem) * 8); }
                  else if (rem == 0) { __syncthreads(); ph_wconv_moe(F, P, L, WC_EARLY, WC_NGU, F.vcu * 8 + F.wave, F.G * 8); } }
                SEAM(); PE(2); }
            if (SITE(4) && IN(base + 3)) { SITE_ENTER(); PB(4); ph_spatial(F, P, j, ROWS / 128); SEAM(); PE(4); }
            if (SITE(5) && IN(base + 4)) {
                SITE_ENTER(); PB(5);
                gm::SchedG S{nullptr, (const char*)WSP(bf16_t, WS_HA), (const char*)(WSP(bf16_t, WS_WAOUT) + (size_t)j * D * D), 2048u, 2048u, 16, 128, 4, 0, 0, 0, 0, ROWS / 256, ROWS / 256, 0, F.G, c};
                gm::EpiRes E{(L == 0) ? P.x : nullptr, (L == 0) ? P.ctx : nullptr, (const bf16_t*)P.out, WSP(bf16_t, WS_XC), (bf16_t*)P.out, WSP(bf16_t, WS_XC), WSP(float, WS_MOD) + (size_t)L * 9 * NMOD + 2 * D, false};
                gm::gemm_units(F.lds, F.tid, S, E); SEAM(); PE(5); }
        } else {
            if (SITE(6) && IN(base + 1)) {
                SITE_ENTER(); PB(6);
                gm::SchedG S{nullptr, (const char*)WSP(bf16_t, WS_HA), (const char*)(WSP(bf16_t, WS_WRIN) + (size_t)j * 5120 * D), 2048u, 2048u, 16, 128, 20, 0, 0, 0, 0, ROWS / 256, ROWS / 256, 0, F.G, c};
                gm::EpiRetIn E{WSP(bf16_t, WS_Q), WSP(bf16_t, WS_K), WSP(bf16_t, WS_KFT), WSP(bf16_t, WS_KBT), WSP(bf16_t, WS_VT), WSP(bf16_t, WS_GF), WSP(bf16_t, WS_GB), WSP(float, WS_ROPE), WSP(float, WS_LOGG) + j * 8, F.lds};
                gm::gemm_units(F.lds, F.tid, S, E); SEAM(); PE(6); }
            if (SITE(7) && IN(base + 2)) {
                SITE_ENTER(); PB(7);
                const int nn2 = last ? 8 : 20, nu1 = 8 * nn2;
                unsigned* cb = (unsigned*)(F.ws + WS_CTL) + CW_HND + (32 + L * 8) * 64;
                { gm::SchedG S{nullptr, (const char*)WSP(bf16_t, WS_HA), (const char*)(WSP(bf16_t, WS_WRIN) + (size_t)j * 5120 * D), 2048u, 2048u, 16, 0, 20, 8, nn2, 128, last ? 4 : 0, ROWS / 256, ROWS / 256, 0, F.G, c};
                  gm::EpiRetIn E{WSP(bf16_t, WS_Q), WSP(bf16_t, WS_K), WSP(bf16_t, WS_KFT), WSP(bf16_t, WS_KBT), WSP(bf16_t, WS_VT), WSP(bf16_t, WS_GF), WSP(bf16_t, WS_GB), WSP(float, WS_ROPE), WSP(float, WS_LOGG) + j * 8, F.lds};
                  gm::gemm_units(F.lds, F.tid, S, E);
                  if (c < nu1) { int pmc, pnc; gm::tile_order(c, 8, nn2, pmc, pnc); handoff_publish(F, cb + pmc * 64); } }
                { gm::SchedState S{(const char*)WSP(bf16_t, WS_VT), (const char*)WSP(bf16_t, WS_KFT), (const char*)WSP(bf16_t, WS_KBT), (unsigned)TOK * 2u, (unsigned)TOK * 2u, F.G, c, 0, 512, 0};
                  gm::EpiBlk E{WSP(bf16_t, WS_UT)};
                  gm::gemm_units(F.lds, F.tid, S, E); }
                if (c >= nu1 && c < nu1 + 64) { const int Lc = 512 + (c - nu1), q = ((Lc >> 3) >> 1) * 8 + (Lc & 7), bhc = q - 256; handoff_wait(F, cb + (bhc >> 2) * 64, (unsigned)nn2); }
                { gm::SchedState S{(const char*)WSP(bf16_t, WS_VT), (const char*)WSP(bf16_t, WS_KFT), (const char*)WSP(bf16_t, WS_KBT), (unsigned)TOK * 2u, (unsigned)TOK * 2u, F.G, c, 512, 64, nu1};
                  gm::EpiBlk E{WSP(bf16_t, WS_UT)};
                  gm::gemm_units(F.lds, F.tid, S, E); }
                SEAM(); PE(7); }
            if (SITE(9) && IN(base + 4)) {
                SITE_ENTER(); PB(9);
                gm::SchedAtt S{(const char*)WSP(bf16_t, WS_Q), (const char*)WSP(bf16_t, WS_K), 2048u, 2048u, 32 * NX * 4, last ? 0 : 32, F.G, c};
                gm::EpiAtt E{WSP(bf16_t, WS_PF), WSP(bf16_t, WS_PB), WSP(float, WS_LOGG) + j * 8};
                gm::gemm_units(F.lds, F.tid, S, E);
                { const int rem = (32 * NX * 4 + 32) % F.G;
                  if (!last && rem > 0 && c >= rem) { __syncthreads(); ph_wconv_moe(F, P, L, WC_EARLY, WC_NGU, (c - rem) * 8 + F.wave, (F.G - rem) * 8); } }
                ph_prefix(F, P, j); SEAM(); PE(9); }
            if (SITE(10) && IN(base + 5)) {
                SITE_ENTER(); PB(10);
                gm::SchedOut S{(const char*)WSP(bf16_t, WS_Q), (const char*)WSP(bf16_t, WS_ST), (const char*)WSP(bf16_t, WS_PF), (const char*)WSP(bf16_t, WS_PB), (const char*)WSP(bf16_t, WS_VT),
                               2048u, 512u, 512u, (unsigned)TOK * 2u, 4, 32 * NX * 4, last ? 0 : 64, F.G, c};
                gm::EpiOut E{WSP(bf16_t, WS_OF), WSP(bf16_t, WS_OB), WSP(float, WS_LOGG) + j * 8};
                gm::gemm_units(F.lds, F.tid, S, E);
                { const int rem = (32 * NX * 4 + 64) % F.G;
                  if (!last && rem > 0 && c >= rem) { __syncthreads(); ph_wconv_moe(F, P, L, WC_NGU + WD_EARLY, WC_NALL, (c - rem) * 8 + F.wave, (F.G - rem) * 8); } }
                SEAM(); PE(10); }
            if (SITE(11) && IN(base + 6)) { SITE_ENTER(); PB(11); ph_headnorm(F, last ? ROWS_L : ROWS); SEAM(); PE(11); }
            if (SITE(12) && IN(base + 7)) {
                SITE_ENTER(); PB(12);
                const int nM = 128;
                gm::SchedG S{nullptr, (const char*)WSP(bf16_t, WS_HA), (const char*)(WSP(bf16_t, WS_WROUT) + (size_t)j * D * D), 2048u, 2048u, 16, nM, 4, 0, 0, 0, 0, ROWS / 256, ROWS / 256, 0, F.G, c};
                gm::EpiRes E{nullptr, nullptr, (const bf16_t*)P.out, WSP(bf16_t, WS_XC), last ? WSP(bf16_t, WS_XALT) : (bf16_t*)P.out, WSP(bf16_t, WS_XC), WSP(float, WS_MOD) + (size_t)L * 9 * NMOD + 2 * D, false};
                gm::gemm_units(F.lds, F.tid, S, E); SEAM(); PE(12); }
        }
        if (SITE(13) && IN(base + 8)) { SITE_ENTER(); PB(13);
            const bool cx = !last; const bool light = cx && c < 32; int tile = 0, quarter = 0;
            unsigned* ctr = (unsigned*)(F.ws + WS_CTL) + CW_HND;
            if (cx) {
                gm::SchedG S{nullptr, (const char*)WSP(bf16_t, WS_HA), (const char*)((kind1 ? WSP(bf16_t, WS_WROUT) : WSP(bf16_t, WS_WAOUT)) + (size_t)j * D * D), 2048u, 2048u, 16, 0, 4, 8, 4, 128, 0, ROWS / 256, ROWS / 256, 0, F.G, c};
                gm::EpiRes E{(L == 0) ? P.x : nullptr, (L == 0) ? P.ctx : nullptr, (const bf16_t*)P.out, WSP(bf16_t, WS_XC), (bf16_t*)P.out, WSP(bf16_t, WS_XC), WSP(float, WS_MOD) + (size_t)L * 9 * NMOD + 2 * D, true};
                gm::gemm_units(F.lds, F.tid, S, E);
                if (light) { gm::tile_order(c, 8, 4, tile, quarter); ctr += (L * 8 + tile) * 64; handoff_publish_wt(F, ctr); }
            }
            if (!light) rt_fill(F, P, L);
            if (!cx) rt_rows<4>(F, P, L, F.vcu * 8 + F.wave, F.G * 8, 0, 1 << 20, false);
            else if (!light) {
                const int fw = (c - 32) * 8 + F.wave, nfw = (F.G - 32) * 8; const int k1 = ((ROWS_L / nfw) / 4) * 4; rt_rows<4>(F, P, L, fw, nfw, 0, k1, false);
                if (F.tid == 0) { unsigned* cb = (unsigned*)(F.ws + WS_CTL) + CW_HND + (L * 8) * 64;
                    for (int t8 = 0; t8 < 8; ++t8) { unsigned sp = 0; while (__hip_atomic_load(cb + t8 * 64, __ATOMIC_RELAXED, __HIP_MEMORY_SCOPE_AGENT) < 4u) { __builtin_amdgcn_s_sleep(2); if (++sp > (1u << 20)) break; } }
                    __builtin_amdgcn_fence(__ATOMIC_ACQUIRE, "agent"); asm volatile("s_waitcnt vmcnt(0)" ::: "memory"); }
                __syncthreads();
                rt_rows<4>(F, P, L, fw, nfw, k1, 1 << 20, true);
            }
            SEAM(); PE(13); }
        if (SITE(14) && IN(base + 9)) { SITE_ENTER(); PB(14); ph_topk(F, last ? 128 : 256); SEAM(); PE(14); }
        {
            const int tpe = last ? 16 : 17;
            if (SITE(16) && IN(base + 11)) {
                SITE_ENTER(); PB(16);
                gm::SchedGT<true> S{WSP(int, WS_IDX), (const char*)WSP(bf16_t, WS_HA), (const char*)WSP(bf16_t, WS_WGU), 2048u, 2048u, 16, NEXP * tpe, 8, 0, 0, 0, 0, tpe, 17, (size_t)2048 * D * 2, F.G, c};
                gm::EpiSwiglu E{WSP(bf16_t, WS_HID)};
                gm::gemm_units(F.lds, F.tid, S, E);
                { const int rem = (NEXP * tpe * 8) % F.G;
                  if (!last && rem > 0 && c >= rem) { __syncthreads(); ph_wconv_moe(F, P, L + 1, WC_NGU, WC_NGU + WD_EARLY, (c - rem) * 8 + F.wave, (F.G - rem) * 8); } }
                SEAM(); PE(16); }
            if (SITE(17) && IN(base + 12)) {
                SITE_ENTER(); PB(17);
                gm::SchedG S{nullptr, (const char*)WSP(bf16_t, WS_HID), (const char*)wd_buf(P, F.ws, L), 2048u, 2048u, 16, NEXP * tpe, 4, 0, 0, 0, 0, tpe, 17, (size_t)D * D * 2, F.G, c};
                gm::EpiDown E{WSP(bf16_t, WS_YE), WSP(float, WS_GATE)};
                gm::gemm_units(F.lds, F.tid, S, E);
                { const int rem = (NEXP * tpe * 4) % F.G;
                  if (!last && rem > 0 && c >= rem) { __syncthreads(); ph_wconv_moe(F, P, L + 1, 0, WC_EARLY, (c - rem) * 8 + F.wave, (F.G - rem) * 8); } }
                SEAM(); PE(17); }
        }
    }
    if (SITE(18) && IN(PH_FINAL)) { SITE_ENTER(); PB(18); ph_final(F, P); PE(18); }
#ifdef PROBE_SITE
    if (blockIdx.x == 0 && threadIdx.x == 0) { const unsigned long long t0 = __builtin_amdgcn_s_memrealtime(), w = probe_acc * PROBE_K; while (__builtin_amdgcn_s_memrealtime() - t0 < w) __builtin_amdgcn_s_sleep(16); }
#endif
#undef IN
#undef SEAM
#undef SITE
#undef SITE_ENTER
}

extern "C" void kernel_launch(void* const* d_in, const int* in_sizes, int n_in, void* d_out, int out_size, void* d_ws, size_t ws_size, hipStream_t stream) {
    static int grid = 0;
    if (grid == 0) {
        if (n_in != 23 || ws_size < WS_END) { fprintf(stderr, "kernel_launch: n_in %d ws %zu (need %zu)\n", n_in, ws_size, (size_t)WS_END); grid = -1; return; }
        int dev = 0, cus = 0;
        if (hipGetDevice(&dev) != hipSuccess || hipDeviceGetAttribute(&cus, hipDeviceAttributeMultiprocessorCount, dev) != hipSuccess) { grid = -1; return; }
        if (hipFuncSetAttribute((const void*)mk_fwd<-1>, hipFuncAttributeMaxDynamicSharedMemorySize, LDS_BYTES) != hipSuccess) { grid = -1; return; }
        (void)hipGetLastError();
        grid = cus & ~7;
    }
    if (grid < 0) return;
    (void)hipMemsetAsync((char*)d_ws + WS_CTL, 0, CTL_ZERO_BYTES, stream);
    Params p{};
    const float** ins = (const float**)&p;
    for (int i = 0; i < 23; ++i) ins[i] = (const float*)d_in[i];
    p.out = (float*)d_out; p.ws = (unsigned char*)d_ws;
    p.ph_lo = 0; p.ph_hi = PH_TOTAL;
    hipLaunchKernelGGL(mk_fwd<-1>, dim3(grid), dim3(512), LDS_BYTES, stream, p);
}
```
